# Optimizing an MI355X kernel written in HIP

```python
import jax
import jax.numpy as jnp
from jax import lax
import numpy as np

D_MODEL = 1024
BATCH = 8
SEQ = 2048
DEPTH = 1

GRID_W = 64
CTX_LEN = 256
POOL_GROUPS = 4
POOL_WINDOWS = (2, 4, 8, 16)
POOL_WIDTH = D_MODEL // 2
POOL_GROUP_DIM = POOL_WIDTH // POOL_GROUPS
RET_HEADS = 8
RET_QK_DIM = D_MODEL // 16
RET_V_DIM = D_MODEL // 8
RET_QK_WIDTH = RET_HEADS * RET_QK_DIM
RET_V_WIDTH = RET_HEADS * RET_V_DIM
RET_CHUNK = 128
K_SCALE = RET_QK_DIM ** -0.5
ROPE_BASE = 10000.0
D_FF = ((8 * D_MODEL + 3 * 256 - 1) // (3 * 256)) * 256
EPS = 1e-6

P_OFF = 0
Q_OFF = P_OFF + POOL_WIDTH
K_OFF = Q_OFF + RET_QK_WIDTH
V_OFF = K_OFF + RET_QK_WIDTH
G_OFF = V_OFF + RET_V_WIDTH
GA_OFF = G_OFF + RET_V_WIDTH
GB_OFF = GA_OFF + D_MODEL
IN_WIDTH = GB_OFF + D_MODEL

kernel_name = 'hybrid_pool_retention_dit_block'


def rms_norm(x, gain):
    xf = x.astype(jnp.float32)
    y = xf * lax.rsqrt(jnp.mean(xf * xf, axis=-1, keepdims=True) + EPS)
    return (y * gain.astype(jnp.float32)).astype(x.dtype)


def modulate(h, shift, scale):
    return h * (1.0 + scale) + shift


def swiglu(h, w1, w3, w2):
    return (jax.nn.silu(h @ w1) * (h @ w3)) @ w2


def centred_box_mean(u, window, axis):
    n = u.shape[axis]
    cs = jnp.cumsum(u.astype(jnp.float32), axis=axis)
    pad = [(0, 0)] * u.ndim
    pad[axis] = (1, 0)
    cs = jnp.pad(cs, pad)
    pos = jnp.arange(n)
    lo = jnp.clip(pos - window // 2, 0, n)
    hi = jnp.clip(pos + (window - window // 2), 0, n)
    total = jnp.take(cs, hi, axis=axis) - jnp.take(cs, lo, axis=axis)
    shape = [1] * u.ndim
    shape[axis] = n
    count = (hi - lo).astype(jnp.float32).reshape(shape)
    return (total / count).astype(u.dtype)


def pool_mixer(u, rows, w_pool, pool_scale):
    B, L, _ = u.shape
    groups = jnp.split(u, POOL_GROUPS, axis=-1)
    diffs = []
    for g, w in enumerate(POOL_WINDOWS):
        ug = groups[g]
        if rows is None:
            m = centred_box_mean(ug, w, 1)
        else:
            grid = ug.reshape(B, rows, GRID_W, POOL_GROUP_DIM)
            m = centred_box_mean(centred_box_mean(grid, w, 2), w, 1).reshape(B, L, POOL_GROUP_DIM)
        diffs.append(m - ug)
    d = jnp.stack(diffs, axis=2)
    y = jnp.einsum('blgc,gcd->blgd', d, w_pool)
    return y.reshape(B, L, POOL_WIDTH) * pool_scale


def rope_2d(length, dtype):
    t = jnp.arange(length)
    row = (t // GRID_W).astype(jnp.float32)
    col = (t % GRID_W).astype(jnp.float32)
    n_freq = RET_QK_DIM // 4
    inv_freq = ROPE_BASE ** (-jnp.arange(n_freq, dtype=jnp.float32) / n_freq)
    ang = jnp.concatenate([row[:, None] * inv_freq, col[:, None] * inv_freq], axis=-1)
    return jnp.cos(ang).astype(dtype), jnp.sin(ang).astype(dtype)


def apply_rope(t, cos, sin):
    half = t.shape[-1] // 2
    t1, t2 = t[..., :half], t[..., half:]
    cos = cos[None, :, None, :]
    sin = sin[None, :, None, :]
    return jnp.concatenate([t1 * cos - t2 * sin, t1 * sin + t2 * cos], axis=-1)


def chunk_retention(q, k, v, log_gamma, s0, include_diag):
    B, L, H, _ = q.shape
    Dv = v.shape[-1]
    C = RET_CHUNK
    n = L // C
    lg = log_gamma.astype(jnp.float32)
    idx = jnp.arange(C, dtype=jnp.float32)
    diff = idx[:, None] - idx[None, :]
    keep = (diff >= 0) if include_diag else (diff > 0)
    intra = jnp.where(keep[None], jnp.exp(lg[:, None, None] * jnp.maximum(diff, 0.0)[None]), 0.0).astype(q.dtype)
    q_dec = jnp.exp(lg[:, None] * (idx + 1.0)).astype(q.dtype)
    k_dec = jnp.exp(lg[:, None] * (C - 1.0 - idx)).astype(q.dtype)
    c_dec = jnp.exp(lg * C).astype(q.dtype)

    def to_chunks(t):
        return t.reshape(B, n, C, H, t.shape[-1]).transpose(1, 0, 3, 2, 4)

    def step(state, chunk):
        qi, ki, vi = chunk
        scores = jnp.einsum('bhqd,bhkd->bhqk', qi, ki) * intra[None]
        out = (jnp.einsum('bhqk,bhkv->bhqv', scores, vi)
               + jnp.einsum('bhqd,bhdv->bhqv', qi * q_dec[None, :, :, None], state))
        state = (state * c_dec[None, :, None, None]
                 + jnp.einsum('bhkd,bhkv->bhdv', ki * k_dec[None, :, :, None], vi))
        return state, out

    _, out = lax.scan(step, s0, (to_chunks(q), to_chunks(k), to_chunks(v)))
    return out.transpose(1, 0, 3, 2, 4).reshape(B, L, H, Dv)


def bidir_retention(q, k, v, lg_f, lg_b, s_f, s_b):
    y_f = chunk_retention(q, k, v, lg_f, s_f, True)
    y_b = chunk_retention(jnp.flip(q, 1), jnp.flip(k, 1), jnp.flip(v, 1), lg_b, s_b, False)
    return y_f + jnp.flip(y_b, 1)


def context_final_states(k, v, lg_f, lg_b):
    Lc = k.shape[1]
    pos = jnp.arange(Lc, dtype=jnp.float32)
    w_f = jnp.exp(lg_f.astype(jnp.float32)[:, None] * (Lc - 1.0 - pos)).astype(k.dtype)
    w_b = jnp.exp(lg_b.astype(jnp.float32)[:, None] * pos).astype(k.dtype)
    s_f = jnp.einsum('hl,blhd,blhv->bhdv', w_f, k, v)
    s_b = jnp.einsum('hl,blhd,blhv->bhdv', w_b, k, v)
    return s_f, s_b


def head_group_norm(y, gain):
    B, L, H, Dv = y.shape
    yf = y.astype(jnp.float32)
    mu = jnp.mean(yf, axis=-1, keepdims=True)
    var = jnp.mean(jnp.square(yf - mu), axis=-1, keepdims=True)
    yn = ((yf - mu) * lax.rsqrt(var + EPS)).reshape(B, L, H * Dv)
    return (yn * gain.astype(jnp.float32)).astype(y.dtype)


def token_mixers(z, rows, rope, s_f, s_b, lg_f, lg_b, w_pool, pool_scale, gn_w, w_pa, w_rb, w_o):
    B, L, _ = z.shape
    u = z[..., P_OFF:Q_OFF]
    q = z[..., Q_OFF:K_OFF].reshape(B, L, RET_HEADS, RET_QK_DIM)
    k = z[..., K_OFF:V_OFF].reshape(B, L, RET_HEADS, RET_QK_DIM) * K_SCALE
    v = z[..., V_OFF:G_OFF].reshape(B, L, RET_HEADS, RET_V_DIM)
    g = z[..., G_OFF:GA_OFF]
    gate_a = jax.nn.sigmoid(z[..., GA_OFF:GB_OFF])
    gate_b = jax.nn.sigmoid(z[..., GB_OFF:IN_WIDTH])
    branch_a = pool_mixer(u, rows, w_pool, pool_scale) @ w_pa
    if rope is not None:
        q = apply_rope(q, rope[0], rope[1])
        k = apply_rope(k, rope[0], rope[1])
    y = bidir_retention(q, k, v, lg_f, lg_b, s_f, s_b)
    y = head_group_norm(y, gn_w) * jax.nn.silu(g)
    branch_b = y @ w_rb
    return (gate_a * branch_a + gate_b * branch_b) @ w_o


def setup_inputs(seed: int = 0) -> dict:
    key = jax.random.key(seed)
    ks = jax.random.split(key, 21)

    def nrm(k, shape, scale):
        return jax.random.normal(k, shape, jnp.float32) * scale

    decay_logit = jnp.log(2.0 ** (5.0 + jnp.arange(RET_HEADS, dtype=jnp.float32)) - 1.0)
    return {
        'x': nrm(ks[0], (BATCH, SEQ, D_MODEL), 1.0),
        'c': nrm(ks[1], (BATCH, D_MODEL), 1.0),
        'ctx': nrm(ks[2], (BATCH, CTX_LEN, D_MODEL), 1.0),
        'c_ctx': nrm(ks[3], (D_MODEL,), 1.0),
        'w_ada': nrm(ks[4], (DEPTH, D_MODEL, 6 * D_MODEL), 0.5 * D_MODEL ** -0.5),
        'b_ada': nrm(ks[5], (DEPTH, 6 * D_MODEL), 0.01),
        'norm_mix': 1.0 + nrm(ks[6], (DEPTH, D_MODEL), 0.05),
        'norm_ffn': 1.0 + nrm(ks[7], (DEPTH, D_MODEL), 0.05),
        'w_in': nrm(ks[8], (DEPTH, D_MODEL, IN_WIDTH), D_MODEL ** -0.5),
        'w_pool': nrm(ks[9], (DEPTH, POOL_GROUPS, POOL_GROUP_DIM, POOL_GROUP_DIM), POOL_GROUP_DIM ** -0.5),
        'pool_scale': 1.0 + nrm(ks[10], (DEPTH, POOL_WIDTH), 0.1),
        'ret_decay_f': decay_logit + nrm(ks[11], (DEPTH, RET_HEADS), 0.1),
        'ret_decay_b': decay_logit + nrm(ks[12], (DEPTH, RET_HEADS), 0.1),
        'ret_gn_w': 1.0 + nrm(ks[13], (DEPTH, RET_V_WIDTH), 0.05),
        'w_pa': nrm(ks[14], (DEPTH, POOL_WIDTH, D_MODEL), POOL_WIDTH ** -0.5),
        'w_rb': nrm(ks[15], (DEPTH, RET_V_WIDTH, D_MODEL), RET_V_WIDTH ** -0.5),
        'w_o': nrm(ks[16], (DEPTH, D_MODEL, D_MODEL), D_MODEL ** -0.5),
        'w_ff1': nrm(ks[17], (DEPTH, D_MODEL, D_FF), D_MODEL ** -0.5),
        'w_ff3': nrm(ks[18], (DEPTH, D_MODEL, D_FF), D_MODEL ** -0.5),
        'w_ff2': nrm(ks[19], (DEPTH, D_FF, D_MODEL), D_FF ** -0.5),
        'norm_final': 1.0 + nrm(ks[20], (D_MODEL,), 0.05),
    }


def reference(x, c, ctx, c_ctx, w_ada, b_ada, norm_mix, norm_ffn, w_in, w_pool, pool_scale,
              ret_decay_f, ret_decay_b, ret_gn_w, w_pa, w_rb, w_o, w_ff1, w_ff3, w_ff2, norm_final):
    B, L, _ = x.shape
    rows = L // GRID_W
    rope = rope_2d(L, x.dtype)
    silu_c = jax.nn.silu(c)
    silu_cc = jax.nn.silu(c_ctx)
    for l in range(DEPTH):
        update_ctx = l < DEPTH - 1
        mod = silu_c @ w_ada[l] + b_ada[l]
        sh_m, sc_m, g_m, sh_f, sc_f, g_f = [m[:, None, :] for m in jnp.split(mod, 6, axis=-1)]
        mod_c = silu_cc @ w_ada[l] + b_ada[l]
        shc_m, scc_m, gc_m, shc_f, scc_f, gc_f = jnp.split(mod_c, 6, axis=-1)
        lg_f = jax.nn.log_sigmoid(ret_decay_f[l])
        lg_b = jax.nn.log_sigmoid(ret_decay_b[l])
        mixer_params = (lg_f, lg_b, w_pool[l], pool_scale[l], ret_gn_w[l], w_pa[l], w_rb[l], w_o[l])

        hc = modulate(rms_norm(ctx, norm_mix[l]), shc_m, scc_m)
        if update_ctx:
            zc = hc @ w_in[l]
            kc_raw, vc_raw = zc[..., K_OFF:V_OFF], zc[..., V_OFF:G_OFF]
        else:
            kvc = hc @ w_in[l][:, K_OFF:G_OFF]
            kc_raw, vc_raw = kvc[..., :RET_QK_WIDTH], kvc[..., RET_QK_WIDTH:]
        Lc = ctx.shape[1]
        kc = kc_raw.reshape(B, Lc, RET_HEADS, RET_QK_DIM) * K_SCALE
        vc = vc_raw.reshape(B, Lc, RET_HEADS, RET_V_DIM)
        s_f, s_b = context_final_states(kc, vc, lg_f, lg_b)

        h = modulate(rms_norm(x, norm_mix[l]), sh_m, sc_m)
        x = x + g_m * token_mixers(h @ w_in[l], rows, rope, s_f, s_b, *mixer_params)
        h = modulate(rms_norm(x, norm_ffn[l]), sh_f, sc_f)
        x = x + g_f * swiglu(h, w_ff1[l], w_ff3[l], w_ff2[l])

        if update_ctx:
            zero_state = jnp.zeros((B, RET_HEADS, RET_QK_DIM, RET_V_DIM), ctx.dtype)
            ctx = ctx + gc_m * token_mixers(zc, None, None, zero_state, zero_state, *mixer_params)
            hc = modulate(rms_norm(ctx, norm_ffn[l]), shc_f, scc_f)
            ctx = ctx + gc_f * swiglu(hc, w_ff1[l], w_ff3[l], w_ff2[l])
    return rms_norm(x, norm_final)
```

```cpp
#include <hip/hip_runtime.h>
#include <hip/hip_cooperative_groups.h>
#include <cstdio>
#include <cstdint>
namespace cg = cooperative_groups;

#ifndef MK_PER_PHASE
#define MK_PER_PHASE 0
#endif

namespace pg8 {
#define PG8_LAS __attribute__((address_space(3)))
typedef unsigned short bf16_t;
typedef short bf16x8 __attribute__((ext_vector_type(8)));
typedef float f32x4 __attribute__((ext_vector_type(4)));
typedef unsigned u32x4 __attribute__((ext_vector_type(4)));
constexpr int BM = 256, BK = 64, HALF = 128, HTB = HALF * BK * 2  , STAGE_BYTES = 8 * HTB, NXCD = 8, WGM = 8;

__host__ __device__ __forceinline__ int lds_byte(int r, int c) { const int st = (r >> 4) * 2 + (c >> 5), rr = r & 15, cc = c & 31, ob = rr * 64 + cc * 2; return st * 1024 + (ob ^ (((ob >> 9) & 1) << 5)); }
__host__ __device__ __forceinline__ void stage_rc(int b, int& R, int& C) { const int st = b / 1024, sb = b % 1024, swz = sb ^ (((sb >> 9) & 1) << 5); R = (st >> 1) * 16 + swz / 64; C = (st & 1) * 32 + (swz % 64) / 2; }
__host__ __device__ __forceinline__ int perm32(int rho) { const int n = rho >> 4, i = rho & 15; return 8 * (i >> 2) + 4 * n + (i & 3); }

struct Unit { int pm, pn, g; };
struct Gemm { const bf16_t* A; const bf16_t* Bt; const bf16_t* A2; const bf16_t* Bt2; int K;
    __device__ __forceinline__ const char* abase(const Unit& u) const { return (const char*)(u.g ? A2 : A) + (size_t)u.pm * (size_t)(2 * HALF) * K * 2; }
    __device__ __forceinline__ const char* bbase(const Unit& u) const { return (const char*)(u.g ? Bt2 : Bt) + (size_t)u.pn * (size_t)(2 * HALF) * K * 2; } };

struct StaticOrder {
    int nM, nN, nwg, G, c;
    int n2M, n2N;
    __host__ __device__ void init(int M, int N, int G_, int c_, int M2 = 0, int N2 = 0) { nM = M / BM; nN = N / BM; nwg = nM * nN; G = G_; c = c_; n2M = M2 / BM; n2N = N2 / BM; }
    __host__ __device__ bool next(int i, Unit& u) const {
        const long L = (long)i * G + c; u.g = 0;
        if (L >= nwg) { const long j = L - nwg; if (j >= (long)n2M * n2N) return false; u.g = 1; u.pm = (int)(j % n2M); u.pn = (int)(j / n2M); return true; }
        int wgid = (int)L; { const int q = nwg / NXCD, r = nwg % NXCD, xcd = wgid % NXCD, off = wgid / NXCD; wgid = (xcd < r ? xcd * (q + 1) : r * (q + 1) + (xcd - r) * q) + off; }
        const int nig = WGM * nN, gid = wgid / nig, fm = gid * WGM, gsz = (nM - fm) < WGM ? (nM - fm) : WGM;
        u.pm = fm + ((wgid % nig) % gsz); u.pn = (wgid % nig) / gsz; return true;
    }
    __device__ __forceinline__ void a_ready(const Unit&) const {}
    __device__ __forceinline__ void done(const Unit&) const {}
};

__device__ __forceinline__ unsigned cvt_pk_bf16(float lo, float hi) { unsigned r; asm volatile("v_cvt_pk_bf16_f32 %0, %1, %2" : "=v"(r) : "v"(lo), "v"(hi)); return r; }


template <class Epi, class Sched, bool ALIGN_EPI = false, bool SP2 = false>
__device__ __forceinline__ void gemm_phase(PG8_LAS unsigned char* lds, const Gemm g, const Sched& S, const Epi& E) {
    const int tid = threadIdx.x, wid = __builtin_amdgcn_readfirstlane(tid >> 6), lane = tid & 63, wr = wid >> 2, wc = wid & 3, fr = lane & 15, fq = lane >> 4;
    const int K = g.K, nt = K / BK;
    unsigned voffA[2], voffB[2];
#pragma unroll
    for (int i = 0; i < 2; ++i) { int R, C; stage_rc(tid * 16 + i * 8192, R, C); const int Rb = Epi::PERM ? ((R & ~31) + perm32(R & 31)) : R;
        voffA[i] = (unsigned)(R * K + C) * 2u; voffB[i] = (unsigned)(Rb * K + C) * 2u; }
    const size_t kstep = (size_t)(BK * 2);
    const size_t hstep = (size_t)HALF * K * 2;
    const unsigned ldsw = (unsigned)wid * 1024u;
    const int aoff = lds_byte(wr * 64 + fr, fq * 8), boff = lds_byte(wc * 32 + fr, fq * 8);
#define PG8_SA(b, h) (((b) * 2 + (h)) * HTB)
#define PG8_SB(b, h) ((4 + (b) * 2 + (h)) * HTB)
#define PG8_STAGE(bufoff, gbase, voff) do { _Pragma("unroll") for (int _i = 0; _i < 2; ++_i) \
        __builtin_amdgcn_global_load_lds((const unsigned*)((const char*)(gbase) + (voff)[_i]), (PG8_LAS unsigned*)(lds + (bufoff) + ldsw + _i * 8192), 16, 0, 0); } while (0)
#define PG8_LDA(dst, b, h) do { _Pragma("unroll") for (int m = 0; m < 4; ++m) _Pragma("unroll") for (int k = 0; k < 2; ++k) dst[m][k] = *(const PG8_LAS bf16x8*)(lds + PG8_SA(b, h) + aoff + m * 2048 + k * 1024); } while (0)
#define PG8_LDB(dst, b, h) do { _Pragma("unroll") for (int n = 0; n < 2; ++n) _Pragma("unroll") for (int k = 0; k < 2; ++k) dst[n][k] = *(const PG8_LAS bf16x8*)(lds + PG8_SB(b, h) + boff + n * 2048 + k * 1024); } while (0)
#define PG8_MMA(ai, bj, At, Bt) do { __builtin_amdgcn_s_setprio(1); _Pragma("unroll") for (int m = 0; m < 4; ++m) _Pragma("unroll") for (int n = 0; n < 2; ++n) _Pragma("unroll") for (int k = 0; k < 2; ++k) \
        acc[ai][bj][m][n] = __builtin_amdgcn_mfma_f32_16x16x32_bf16(Bt[n][k], At[m][k], acc[ai][bj][m][n], 0, 0, 0); __builtin_amdgcn_s_setprio(0); } while (0)
#define PG8_WAIT_V(n) asm volatile("s_waitcnt vmcnt(" #n ")" ::: "memory")
#define PG8_WAIT_L(n) asm volatile("s_waitcnt lgkmcnt(" #n ")" ::: "memory")
#define PG8_BAR __builtin_amdgcn_s_barrier()
#define PG8_SCHED __builtin_amdgcn_sched_barrier(0)
    Unit cur, nxt; int ui = 0;
    if (!S.next(0, cur)) return;
    f32x4 acc[2][2][4][2];
#pragma unroll
    for (int a = 0; a < 2; ++a)
#pragma unroll
        for (int b = 0; b < 2; ++b)
#pragma unroll
            for (int m = 0; m < 4; ++m)
#pragma unroll
                for (int n = 0; n < 2; ++n) acc[a][b][m][n] = (f32x4){0.f, 0.f, 0.f, 0.f};
    bf16x8 At[4][2], B0[2][2], B1[2][2];
    const char* cA = g.abase(cur); const char* cB = g.bbase(cur);
    S.a_ready(cur);
    if constexpr (SP2) {
        PG8_STAGE(PG8_SB(0, 0), cB, voffB); PG8_STAGE(PG8_SB(0, 1), cB + hstep, voffB); PG8_STAGE(PG8_SA(0, 0), cA, voffA); PG8_STAGE(PG8_SA(0, 1), cA + hstep, voffA);
        if (wr == 1) PG8_BAR;
        PG8_WAIT_V(2); PG8_BAR;
        PG8_STAGE(PG8_SB(1, 0), cB + kstep, voffB); PG8_STAGE(PG8_SA(1, 0), cA + kstep, voffA); PG8_STAGE(PG8_SB(1, 1), cB + hstep + kstep, voffB);
        PG8_WAIT_V(6); PG8_BAR;
    } else {
        PG8_STAGE(PG8_SB(0, 0), cB, voffB); PG8_STAGE(PG8_SA(0, 0), cA, voffA); PG8_STAGE(PG8_SB(0, 1), cB + hstep, voffB); PG8_STAGE(PG8_SA(0, 1), cA + hstep, voffA);
        if (wr == 1) PG8_BAR;
        PG8_WAIT_V(4); PG8_BAR;
        PG8_STAGE(PG8_SB(1, 0), cB + kstep, voffB); PG8_STAGE(PG8_SA(1, 0), cA + kstep, voffA); PG8_STAGE(PG8_SB(1, 1), cB + hstep + kstep, voffB);
        PG8_WAIT_V(6); PG8_BAR;
    }
    for (;;) {
        const bool has_next = S.next(ui + 1, nxt);
        const char* nA = has_next ? g.abase(nxt) : cA; const char* nB = has_next ? g.bbase(nxt) : cB;
        for (int t = 0; t < nt; t += 2) {
            const bool last = (t == nt - 2);
            const char* a1 = cA + (size_t)(t + 1) * kstep;
            const char* a2 = last ? nA : cA + (size_t)(t + 2) * kstep; const char* b2 = last ? nB : cB + (size_t)(t + 2) * kstep;
            const char* a3 = a2 + kstep; const char* b3 = b2 + kstep;
            if (last && has_next) S.a_ready(nxt);
            if constexpr (SP2) {
            PG8_LDB(B0, 0, 0); PG8_LDB(B1, 0, 1); PG8_SCHED; PG8_LDA(At, 0, 0); PG8_STAGE(PG8_SA(1, 1), a1 + hstep, voffA);
            PG8_WAIT_V(8); PG8_WAIT_L(0); PG8_BAR; PG8_MMA(0, 0, At, B0); PG8_MMA(0, 1, At, B1); PG8_BAR; PG8_SCHED;
            PG8_LDA(At, 0, 1); PG8_STAGE(PG8_SB(0, 0), b2, voffB); PG8_STAGE(PG8_SB(0, 1), b2 + hstep, voffB); PG8_STAGE(PG8_SA(0, 0), a2, voffA);
            PG8_WAIT_V(8); PG8_WAIT_L(0); PG8_BAR; PG8_MMA(1, 0, At, B0); PG8_MMA(1, 1, At, B1); PG8_BAR; PG8_SCHED;
            PG8_LDB(B0, 1, 0); PG8_LDB(B1, 1, 1); PG8_SCHED; PG8_LDA(At, 1, 0); PG8_STAGE(PG8_SA(0, 1), a2 + hstep, voffA);
            PG8_WAIT_V(8); PG8_WAIT_L(0); PG8_BAR; PG8_MMA(0, 0, At, B0); PG8_MMA(0, 1, At, B1); PG8_BAR; PG8_SCHED;
            PG8_LDA(At, 1, 1); PG8_STAGE(PG8_SB(1, 0), b3, voffB); PG8_STAGE(PG8_SB(1, 1), b3 + hstep, voffB); PG8_STAGE(PG8_SA(1, 0), a3, voffA);
            PG8_WAIT_V(8); PG8_WAIT_L(0); PG8_BAR; PG8_MMA(1, 0, At, B0); PG8_MMA(1, 1, At, B1); PG8_BAR; PG8_SCHED;
            } else {
            PG8_LDB(B0, 0, 0); PG8_SCHED; PG8_LDA(At, 0, 0); PG8_STAGE(PG8_SA(1, 1), a1 + hstep, voffA);
            PG8_WAIT_L(8); PG8_BAR; PG8_WAIT_L(0); PG8_MMA(0, 0, At, B0); PG8_BAR; PG8_SCHED;
            PG8_LDB(B1, 0, 1); PG8_STAGE(PG8_SB(0, 0), b2, voffB);
            PG8_BAR; PG8_WAIT_L(0); PG8_MMA(0, 1, At, B1); PG8_BAR;
            PG8_LDA(At, 0, 1); PG8_STAGE(PG8_SA(0, 0), a2, voffA);
            PG8_BAR; PG8_WAIT_L(0); PG8_MMA(1, 0, At, B0); PG8_BAR; PG8_SCHED;
            PG8_STAGE(PG8_SB(0, 1), b2 + hstep, voffB);
            PG8_WAIT_V(6); PG8_BAR; PG8_MMA(1, 1, At, B1); PG8_BAR;
            PG8_LDB(B0, 1, 0); PG8_SCHED; PG8_LDA(At, 1, 0); PG8_STAGE(PG8_SA(0, 1), a2 + hstep, voffA);
            PG8_WAIT_L(8); PG8_BAR; PG8_WAIT_L(0); PG8_MMA(0, 0, At, B0); PG8_BAR; PG8_SCHED;
            PG8_LDB(B1, 1, 1); PG8_STAGE(PG8_SB(1, 0), b3, voffB);
            PG8_BAR; PG8_WAIT_L(0); PG8_MMA(0, 1, At, B1); PG8_BAR;
            PG8_LDA(At, 1, 1); PG8_STAGE(PG8_SA(1, 0), a3, voffA);
            PG8_BAR; PG8_WAIT_L(0); PG8_MMA(1, 0, At, B0); PG8_BAR; PG8_SCHED;
            PG8_STAGE(PG8_SB(1, 1), b3 + hstep, voffB);
            PG8_WAIT_V(6); PG8_BAR; PG8_MMA(1, 1, At, B1); PG8_BAR;
            }
        }
        if constexpr (ALIGN_EPI) { if (wr == 0) PG8_BAR; }
        if constexpr (!Epi::AFTER_DRAIN) { E(acc, cur, wr, wc, fr, fq); S.done(cur); }
        if (!has_next) break;
#pragma unroll
        for (int a = 0; a < 2; ++a)
#pragma unroll
            for (int b = 0; b < 2; ++b)
#pragma unroll
                for (int m = 0; m < 4; ++m)
#pragma unroll
                    for (int n = 0; n < 2; ++n) acc[a][b][m][n] = (f32x4){0.f, 0.f, 0.f, 0.f};
        cur = nxt; cA = nA; cB = nB; ++ui;
        if constexpr (ALIGN_EPI) { if (wr == 1) PG8_BAR; }
    }
    PG8_WAIT_V(0);
    if constexpr (!ALIGN_EPI) { if (wr == 0) PG8_BAR; }
    PG8_BAR;
    if constexpr (Epi::AFTER_DRAIN) { E.fused(acc, cur, wr, wc, fr, fq, lds, wid, lane); S.done(cur); }
#undef PG8_SA
#undef PG8_SB
#undef PG8_STAGE
#undef PG8_LDA
#undef PG8_LDB
#undef PG8_MMA
#undef PG8_WAIT_V
#undef PG8_WAIT_L
#undef PG8_BAR
#undef PG8_SCHED
}
}

using pg8::f32x4; using pg8::bf16x8; using pg8::u32x4; using pg8::Unit;
#define LAS __attribute__((address_space(3)))
typedef unsigned short bf16;
typedef unsigned u32x2 __attribute__((ext_vector_type(2)));
typedef float f32x2_t __attribute__((ext_vector_type(2)));
typedef __bf16 bf16x2_t __attribute__((ext_vector_type(2)));
#define LDS_WAIT() asm volatile("s_waitcnt lgkmcnt(0)" ::: "memory")

constexpr int NWAVES = 8, NTHR = 512;
constexpr int DM = 1024, NB = 8, SL = 2048, MT = NB * SL, LCX = 256, MCX = NB * LCX;
constexpr int INW = 5632, DFF = 2816, PWD = 512, NH = 8, DK = 64, DV = 128;
constexpr int Q_OFF = 512, K_OFF = 1024, V_OFF = 1536, G_OFF = 2560, GA_OFF = 3584, GB_OFF = 4608;
constexpr int NPOS = 18, NCH = 16, MODW = 6 * DM, NKC = 4;
constexpr float EPS = 1e-6f, LOG2E = 1.4426950408889634f;
constexpr int LDS_BYTES = 147456;
constexpr int NPHASE = 12;

constexpr size_t MiB = 1u << 20;
constexpr size_t WS_W13 = 1 * MiB, WS_W2 = 12 * MiB, WS_WCOMB = 17 * MiB + MiB / 2, WS_WRB = 18 * MiB + MiB / 2, WS_WO = 20 * MiB + MiB / 2;
constexpr size_t WS_MODP = 22 * MiB + MiB / 2, WS_MOD = 23 * MiB + MiB / 2, WS_Z = 24 * MiB, WS_SA = 200 * MiB, WS_END = 256 * MiB;
constexpr size_t WS_WIN = WS_SA, WS_H = WS_SA + 11 * MiB, WS_HC = WS_SA + 43 * MiB, WS_ZC = WS_SA + 47 * MiB;
constexpr size_t WS_D = WS_SA, WS_ST = WS_SA + 16 * MiB, WS_MERGED = WS_SA + 16 * MiB, WS_H2 = WS_SA, WS_HMID = WS_Z;
static_assert(WS_ZC + (size_t)MCX * 1536 * 2 <= WS_END && WS_ST + (size_t)64 * 16 * 16384 * 2 <= WS_END && WS_Z + (size_t)MT * INW * 2 <= WS_SA, "ws map");
static_assert((size_t)NKC * 9 * MODW * 4 <= MiB && (size_t)64 * NPOS * 16384 * 2 <= (size_t)MT * DM * 4, "ws map 2");

__device__ __forceinline__ unsigned pk2(float lo, float hi) { f32x2_t v = {lo, hi}; bf16x2_t b = __builtin_convertvector(v, bf16x2_t); return __builtin_bit_cast(unsigned, b); }
__device__ __forceinline__ bf16 f2bf(float f) { return (bf16)(pk2(f, 0.f) & 0xffffu); }
__device__ __forceinline__ float bflo(unsigned u) { return __uint_as_float(u << 16); }
__device__ __forceinline__ float bfhi(unsigned u) { return __uint_as_float(u & 0xffff0000u); }
__device__ __forceinline__ float bf1(bf16 v) { return __uint_as_float((unsigned)v << 16); }
__device__ __forceinline__ float wave_sum(float v) {
#pragma unroll
    for (int o = 1; o < 64; o <<= 1) v += __shfl_xor(v, o);
    return v;
}
__device__ __forceinline__ float sigmoid_(float x) { return __builtin_amdgcn_rcpf(1.f + __builtin_amdgcn_exp2f(-x * LOG2E)); }
__device__ __forceinline__ float silu_(float x) { return x * sigmoid_(x); }
__device__ __forceinline__ float ex2(float x) { return __builtin_amdgcn_exp2f(x); }
__device__ __forceinline__ float log2_sigmoid(float x) { return -log1pf(expf(-x)) * LOG2E; }
__device__ __forceinline__ void unpack8(const u32x4 r, float (&f)[8]) {
    f[0] = bflo(r.x); f[1] = bfhi(r.x); f[2] = bflo(r.y); f[3] = bfhi(r.y); f[4] = bflo(r.z); f[5] = bfhi(r.z); f[6] = bflo(r.w); f[7] = bfhi(r.w);
}
__device__ __forceinline__ u32x4 pack8(const float (&f)[8]) { u32x4 o; o.x = pk2(f[0], f[1]); o.y = pk2(f[2], f[3]); o.z = pk2(f[4], f[5]); o.w = pk2(f[6], f[7]); return o; }

struct EpiZ {
    static constexpr bool PERM = true, AFTER_DRAIN = false;
    bf16* Z; bf16* ZC;
    __device__ __forceinline__ void operator()(const f32x4 (&acc)[2][2][4][2], const Unit& u, int wr, int wc, int fr, int fq) const {
        bf16* base = u.g ? ZC : Z; const int ldc = u.g ? 1536 : INW; const bool sig = (u.g == 0) && (u.pn >= GA_OFF / 256);
        const int row0 = u.pm * 256 + wr * 64 + fr, col0 = u.pn * 256 + wc * 32 + 8 * fq;
#pragma unroll
        for (int ai = 0; ai < 2; ++ai)
#pragma unroll
            for (int m = 0; m < 4; ++m) { bf16* rowp = base + (size_t)(row0 + ai * 128 + m * 16) * ldc + col0;
#pragma unroll
                for (int bj = 0; bj < 2; ++bj) { f32x4 v0 = acc[ai][bj][m][0], v1 = acc[ai][bj][m][1];
                    if (sig) {
#pragma unroll
                        for (int e = 0; e < 4; ++e) { v0[e] = sigmoid_(v0[e]); v1[e] = sigmoid_(v1[e]); } }
                    u32x4 w; w.x = pk2(v0[0], v0[1]); w.y = pk2(v0[2], v0[3]); w.z = pk2(v1[0], v1[1]); w.w = pk2(v1[2], v1[3]);
                    *(u32x4*)(rowp + bj * 128) = w; } }
    }
};
template <bool ADD> struct EpiGate {
    static constexpr bool PERM = true, AFTER_DRAIN = false;
    const bf16* Z; int goff; bf16* O;
    __device__ __forceinline__ void operator()(const f32x4 (&acc)[2][2][4][2], const Unit& u, int wr, int wc, int fr, int fq) const {
        const int row0 = u.pm * 256 + wr * 64 + fr, col0 = u.pn * 256 + wc * 32 + 8 * fq;
#pragma unroll
        for (int ai = 0; ai < 2; ++ai)
#pragma unroll
            for (int m = 0; m < 4; ++m) { const size_t row = (size_t)(row0 + ai * 128 + m * 16);
#pragma unroll
                for (int bj = 0; bj < 2; ++bj) { const int col = col0 + bj * 128;
                    float gt[8], o[8]; unpack8(*(const u32x4*)(Z + row * INW + goff + col), gt);
                    if (ADD) unpack8(*(const u32x4*)(O + row * DM + col), o);
#pragma unroll
                    for (int e = 0; e < 8; ++e) { const float a = acc[ai][bj][m][e >> 2][e & 3]; o[e] = ADD ? (o[e] + gt[e] * a) : (gt[e] * a); }
                    *(u32x4*)(O + row * DM + col) = pack8(o); } }
    }
};
struct EpiRes {
    static constexpr bool PERM = true, AFTER_DRAIN = false;
    const float* base; float* out; const float* mod; int goff;
    __device__ __forceinline__ void operator()(const f32x4 (&acc)[2][2][4][2], const Unit& u, int wr, int wc, int fr, int fq) const {
        const int row0 = u.pm * 256 + wr * 64 + fr, col0 = u.pn * 256 + wc * 32 + 8 * fq, b = u.pm >> 3;
        const float* gp = mod + (size_t)b * MODW + goff + col0;
        f32x4 gv[2][2];
#pragma unroll
        for (int bj = 0; bj < 2; ++bj)
#pragma unroll
            for (int n = 0; n < 2; ++n) gv[bj][n] = *(const f32x4*)(gp + bj * 128 + 4 * n);
#pragma unroll
        for (int ai = 0; ai < 2; ++ai)
#pragma unroll
            for (int m = 0; m < 4; ++m) { const size_t ro = (size_t)(row0 + ai * 128 + m * 16) * DM + col0;
#pragma unroll
                for (int bj = 0; bj < 2; ++bj)
#pragma unroll
                    for (int n = 0; n < 2; ++n) { const f32x4 bv = *(const f32x4*)(base + ro + bj * 128 + 4 * n);
                        *(f32x4*)(out + ro + bj * 128 + 4 * n) = bv + gv[bj][n] * acc[ai][bj][m][n]; } }
    }
};
struct EpiSwiglu {
    static constexpr bool PERM = true, AFTER_DRAIN = false;
    bf16* O;
    __device__ __forceinline__ void operator()(const f32x4 (&acc)[2][2][4][2], const Unit& u, int wr, int wc, int fr, int fq) const {
        const int row0 = u.pm * 256 + wr * 64 + fr, col0 = u.pn * 128 + wc * 32 + 8 * fq;
#pragma unroll
        for (int ai = 0; ai < 2; ++ai)
#pragma unroll
            for (int m = 0; m < 4; ++m) { float o[8];
#pragma unroll
                for (int e = 0; e < 8; ++e) o[e] = silu_(acc[ai][0][m][e >> 2][e & 3]) * acc[ai][1][m][e >> 2][e & 3];
                *(u32x4*)(O + (size_t)(row0 + ai * 128 + m * 16) * DFF + col0) = pack8(o); }
    }
};

__device__ __forceinline__ void transpose_item(const float* __restrict__ W, int K, int N, bf16* WT, int mode, LAS float* scr, int item, int lane) {
    const int nblk = N / 32, kb = item / nblk, nb = item % nblk, k0 = 64 * kb, n0 = 32 * nb;
#pragma unroll 8
    for (int i = 0; i < 32; ++i) { const int kk = 2 * i + (lane >> 5); scr[kk * 33 + (lane & 31)] = W[(size_t)(k0 + kk) * N + n0 + (lane & 31)]; }
    LDS_WAIT(); asm volatile("" ::: "memory");
    const int c = lane & 7;
    const int drow0 = (mode == 0) ? n0 : (256 * (n0 >> 7) + (n0 & 127) + (mode == 2 ? 128 : 0));
#pragma unroll
    for (int j = 0; j < 4; ++j) { const int n = (lane >> 3) + 8 * j; const LAS float* s = scr + (8 * c) * 33 + n;
        u32x4 o; o.x = pk2(s[0 * 33], s[1 * 33]); o.y = pk2(s[2 * 33], s[3 * 33]); o.z = pk2(s[4 * 33], s[5 * 33]); o.w = pk2(s[6 * 33], s[7 * 33]);
        *(u32x4*)(WT + (size_t)(drow0 + n) * K + k0 + 8 * c) = o; }
    LDS_WAIT(); asm volatile("" ::: "memory");
}
__device__ __forceinline__ void wcomb_item(const float* __restrict__ w_pool, const float* __restrict__ pscale, const float* __restrict__ w_pa, bf16* WcT, int item, int lane) {
    const int g = item >> 6, n0 = (item & 63) * 16;
    float a0[16], a1[16];
#pragma unroll
    for (int n = 0; n < 16; ++n) { a0[n] = 0.f; a1[n] = 0.f; }
    const float* p0 = w_pool + ((size_t)(g * 128 + lane)) * 128; const float* p1 = p0 + 64 * 128;
    for (int d4 = 0; d4 < 32; ++d4) {
        const f32x4 x0 = *(const f32x4*)(p0 + 4 * d4), x1 = *(const f32x4*)(p1 + 4 * d4);
#pragma unroll
        for (int dd = 0; dd < 4; ++dd) { const int d = g * 128 + 4 * d4 + dd; const float ps = pscale[d]; const float* wp = w_pa + (size_t)d * DM + n0;
#pragma unroll
            for (int n = 0; n < 16; ++n) { const float bb = wp[n] * ps; a0[n] += x0[dd] * bb; a1[n] += x1[dd] * bb; } }
    }
#pragma unroll
    for (int n = 0; n < 16; ++n) { WcT[(size_t)(n0 + n) * PWD + g * 128 + lane] = f2bf(a0[n]); WcT[(size_t)(n0 + n) * PWD + g * 128 + 64 + lane] = f2bf(a1[n]); }
}
__device__ __forceinline__ void ada_item(const float* __restrict__ cnd, const float* __restrict__ cctx, const float* __restrict__ w_ada, float* MODP, int item, int lane) {
    const int cb = item % 96, kc = item / 96, col = cb * 64 + lane;
    float acc[9];
#pragma unroll
    for (int b = 0; b < 9; ++b) acc[b] = 0.f;
    for (int sub = 0; sub < 4; ++sub) {
        const int kb = kc * 256 + sub * 64;
        float sv[9];
#pragma unroll
        for (int b = 0; b < 9; ++b) { const float x = (b < 8) ? cnd[b * DM + kb + lane] : cctx[kb + lane]; sv[b] = x / (1.f + expf(-x)); }
        const float* wp = w_ada + (size_t)kb * MODW + col;
#pragma unroll
        for (int kk = 0; kk < 64; ++kk) { const float w = wp[(size_t)kk * MODW];
#pragma unroll
            for (int b = 0; b < 9; ++b) acc[b] += __int_as_float(__builtin_amdgcn_readlane(__float_as_int(sv[b]), kk)) * w; }
    }
#pragma unroll
    for (int b = 0; b < 9; ++b) MODP[((size_t)kc * 9 + b) * MODW + col] = acc[b];
}

__device__ __forceinline__ void p1_norm(const float* __restrict__ x, const float* __restrict__ ctx, const float* __restrict__ gain, const float* __restrict__ b_ada, const float* MODP,
                                         bf16* H, bf16* HC, int gw, int NGW, int lane) {
    const int total = MT + MCX, per = (total + NGW - 1) / NGW, r0 = gw * per, r1 = (r0 + per < total) ? r0 + per : total;
    int curb = -1; f32x4 gs[4], sh[4];
    for (int r = r0; r < r1; ++r) {
        const int b = (r < MT) ? (r >> 11) : 8;
        if (b != curb) { curb = b;
#pragma unroll
            for (int j = 0; j < 4; ++j) { const int col = 4 * lane + 256 * j;
                f32x4 s = *(const f32x4*)(b_ada + col), c = *(const f32x4*)(b_ada + DM + col);
#pragma unroll
                for (int kc = 0; kc < NKC; ++kc) { s += *(const f32x4*)(MODP + ((size_t)kc * 9 + b) * MODW + col); c += *(const f32x4*)(MODP + ((size_t)kc * 9 + b) * MODW + DM + col); }
                const f32x4 g = *(const f32x4*)(gain + col);
                sh[j] = s; gs[j] = g * (c + 1.0f); } }
        const float* src = (r < MT) ? x + (size_t)r * DM : ctx + (size_t)(r - MT) * DM;
        bf16* dst = (r < MT) ? H + (size_t)r * DM : HC + (size_t)(r - MT) * DM;
        f32x4 v[4]; float ss = 0.f;
#pragma unroll
        for (int j = 0; j < 4; ++j) { v[j] = *(const f32x4*)(src + 4 * lane + 256 * j); ss += (v[j].x * v[j].x + v[j].y * v[j].y) + (v[j].z * v[j].z + v[j].w * v[j].w); }
        const float rstd = rsqrtf(wave_sum(ss) * (1.f / DM) + EPS);
#pragma unroll
        for (int j = 0; j < 4; ++j) { const f32x4 o = v[j] * rstd * gs[j] + sh[j]; u32x2 w; w.x = pk2(o.x, o.y); w.y = pk2(o.z, o.w); *(u32x2*)(dst + 4 * lane + 256 * j) = w; }
    }
}
__device__ __forceinline__ void p8_norm(const float* x1, const float* __restrict__ gain, const float* MOD, bf16* H2, int gw, int NGW, int lane) {
    const int per = (MT + NGW - 1) / NGW, r0 = gw * per, r1 = (r0 + per < MT) ? r0 + per : MT;
    int curb = -1; f32x4 gs[4], sh[4];
    for (int r = r0; r < r1; ++r) {
        const int b = r >> 11;
        if (b != curb) { curb = b;
#pragma unroll
            for (int j = 0; j < 4; ++j) { const int col = 4 * lane + 256 * j;
                const f32x4 s = *(const f32x4*)(MOD + (size_t)b * MODW + 3 * DM + col), c = *(const f32x4*)(MOD + (size_t)b * MODW + 4 * DM + col), g = *(const f32x4*)(gain + col);
                sh[j] = s; gs[j] = g * (c + 1.0f); } }
        const float* src = x1 + (size_t)r * DM; bf16* dst = H2 + (size_t)r * DM;
        f32x4 v[4]; float ss = 0.f;
#pragma unroll
        for (int j = 0; j < 4; ++j) { v[j] = *(const f32x4*)(src + 4 * lane + 256 * j); ss += (v[j].x * v[j].x + v[j].y * v[j].y) + (v[j].z * v[j].z + v[j].w * v[j].w); }
        const float rstd = rsqrtf(wave_sum(ss) * (1.f / DM) + EPS);
#pragma unroll
        for (int j = 0; j < 4; ++j) { const f32x4 o = v[j] * rstd * gs[j] + sh[j]; u32x2 w; w.x = pk2(o.x, o.y); w.y = pk2(o.z, o.w); *(u32x2*)(dst + 4 * lane + 256 * j) = w; }
    }
}
__device__ __forceinline__ void p11_norm(float* out, const float* __restrict__ gain, int gw, int NGW, int lane) {
    f32x4 g[4];
#pragma unroll
    for (int j = 0; j < 4; ++j) g[j] = *(const f32x4*)(gain + 4 * lane + 256 * j);
    for (int r = gw; r < MT; r += NGW) {
        float* p = out + (size_t)r * DM;
        f32x4 v[4]; float ss = 0.f;
#pragma unroll
        for (int j = 0; j < 4; ++j) { v[j] = *(const f32x4*)(p + 4 * lane + 256 * j); ss += (v[j].x * v[j].x + v[j].y * v[j].y) + (v[j].z * v[j].z + v[j].w * v[j].w); }
        const float rstd = rsqrtf(wave_sum(ss) * (1.f / DM) + EPS);
#pragma unroll
        for (int j = 0; j < 4; ++j) *(f32x4*)(p + 4 * lane + 256 * j) = v[j] * rstd * g[j];
    }
}

__device__ __forceinline__ int vt_off(int v, int j) { return v * 272 + ((((j >> 3) ^ (v >> 3)) & 15) << 4) + (j & 7) * 2; }
__device__ __forceinline__ void stage_vt(LAS unsigned char* vt, const bf16* vbase, int ld, int tid) {
    const int vseg = tid & 15, j0 = (tid >> 4) * 4;
    u32x4 r[4];
#pragma unroll
    for (int jj = 0; jj < 4; ++jj) r[jj] = *(const u32x4*)(vbase + (size_t)(j0 + jj) * ld + vseg * 8);
#pragma unroll
    for (int e2 = 0; e2 < 4; ++e2) {
        const unsigned a0 = r[0][e2], a1 = r[1][e2], a2 = r[2][e2], a3 = r[3][e2];
        u32x2 lo, hi; lo.x = (a0 & 0xffffu) | (a1 << 16); lo.y = (a2 & 0xffffu) | (a3 << 16); hi.x = (a0 >> 16) | (a1 & 0xffff0000u); hi.y = (a2 >> 16) | (a3 & 0xffff0000u);
        const int v = vseg * 8 + 2 * e2;
        *(LAS u32x2*)(vt + vt_off(v, j0)) = lo; *(LAS u32x2*)(vt + vt_off(v + 1, j0)) = hi;
    }
}
__device__ __forceinline__ void rope_cs(int tok, int f, float& cs, float& sn) {
    const float pos = (float)((f < 16) ? (tok >> 6) : (tok & 63));
    const float ang = pos * ex2(-(float)(f & 15) * 0.8304820237218406f);
    cs = __cosf(ang); sn = __sinf(ang);
}
__device__ __forceinline__ void a_item(LAS unsigned char* lds, const bf16* Z, const bf16* ZC, bf16* AT, float lgf2, float lgb2, int b, int h, int pos, int tid, int wave, int lane) {
    LAS unsigned char* Vt = lds; LAS unsigned char* Kt = lds + 34816;
    const bool lat = pos >= 2; const int c = pos - 2;
    const bf16* kbase = lat ? Z + ((size_t)b * SL + c * 128) * INW + K_OFF + h * DK : ZC + ((size_t)b * LCX + pos * 128) * 1536 + h * DK;
    const bf16* vbase = lat ? Z + ((size_t)b * SL + c * 128) * INW + V_OFF + h * DV : ZC + ((size_t)b * LCX + pos * 128) * 1536 + 512 + h * DV;
    const int ld = lat ? INW : 1536;
    stage_vt(Vt, vbase, ld, tid);
    if (tid < 256) {
        const int tt = tid & 127, dir = tid >> 7, ds = tt & 3, j0 = (tt >> 2) * 4, d0 = ds * 8;
        const float lg2 = dir ? lgb2 : lgf2;
        unsigned p1[8][2], p2[8][2];
#pragma unroll
        for (int jp = 0; jp < 2; ++jp) {
            float o1[2][8], o2[2][8];
#pragma unroll
            for (int q = 0; q < 2; ++q) { const int j = j0 + 2 * jp + q;
                float x1[8], x2[8]; unpack8(*(const u32x4*)(kbase + (size_t)j * ld + d0), x1); unpack8(*(const u32x4*)(kbase + (size_t)j * ld + 32 + d0), x2);
                const float dec = ex2(lg2 * (float)(dir ? j : 127 - j)) * 0.125f;
#pragma unroll
                for (int e = 0; e < 8; ++e) {
                    float a = x1[e], bb = x2[e];
                    if (lat) { float cs, sn; rope_cs(c * 128 + j, d0 + e, cs, sn); const float t1 = a * cs - bb * sn, t2 = a * sn + bb * cs; a = t1; bb = t2; }
                    o1[q][e] = a * dec; o2[q][e] = bb * dec; } }
#pragma unroll
            for (int e = 0; e < 8; ++e) { p1[e][jp] = pk2(o1[0][e], o1[1][e]); p2[e][jp] = pk2(o2[0][e], o2[1][e]); }
        }
#pragma unroll
        for (int e = 0; e < 8; ++e) { u32x2 w1, w2; w1.x = p1[e][0]; w1.y = p1[e][1]; w2.x = p2[e][0]; w2.y = p2[e][1];
            *(LAS u32x2*)(Kt + vt_off(dir * 64 + d0 + e, j0)) = w1; *(LAS u32x2*)(Kt + vt_off(dir * 64 + 32 + d0 + e, j0)) = w2; }
    }
    __syncthreads();
    const int fr = lane & 15, fq = lane >> 4;
    f32x4 acc[8];
#pragma unroll
    for (int ct = 0; ct < 8; ++ct) acc[ct] = (f32x4){0.f, 0.f, 0.f, 0.f};
#pragma unroll
    for (int ks = 0; ks < 4; ++ks) {
        const bf16x8 a = *(const LAS bf16x8*)(Vt + vt_off(16 * wave + fr, 32 * ks + 8 * fq));
#pragma unroll
        for (int ct = 0; ct < 8; ++ct) { const bf16x8 bb = *(const LAS bf16x8*)(Kt + vt_off(16 * ct + fr, 32 * ks + 8 * fq)); acc[ct] = __builtin_amdgcn_mfma_f32_16x16x32_bf16(a, bb, acc[ct], 0, 0, 0); }
    }
    bf16* ob = AT + ((size_t)((b * NH + h) * NPOS + pos)) * 16384;
#pragma unroll
    for (int ct = 0; ct < 8; ++ct)
#pragma unroll
        for (int r = 0; r < 4; ++r) ob[(16 * wave + 4 * fq + r) * 128 + 16 * ct + fr] = f2bf(acc[ct][r]);
    __syncthreads();
}
__device__ __forceinline__ void pool_item(LAS unsigned char* lds, const bf16* Z, bf16* Db, int b, int g, int r, int chh, int tid) {
    LAS float* cs = (LAS float*)lds;
    const int c = tid >> 3, sg = tid & 7, ch0 = g * 128 + chh * 64 + sg * 8, hw = 1 << g;
    const int rlo = (r - hw > 0) ? r - hw : 0, rhi = (r + hw < 32) ? r + hw : 32, clo = (c - hw > 0) ? c - hw : 0, chi = (c + hw < 64) ? c + hw : 64;
    float sum[8], own[8];
#pragma unroll
    for (int e = 0; e < 8; ++e) { sum[e] = 0.f; own[e] = 0.f; }
    for (int rr = rlo; rr < rhi; ++rr) {
        float x[8]; unpack8(*(const u32x4*)(Z + ((size_t)b * SL + rr * 64 + c) * INW + ch0), x);
#pragma unroll
        for (int e = 0; e < 8; ++e) { sum[e] += x[e]; if (rr == r) own[e] = x[e]; }
    }
    *(LAS f32x4*)(cs + c * 68 + sg * 8) = (f32x4){sum[0], sum[1], sum[2], sum[3]}; *(LAS f32x4*)(cs + c * 68 + sg * 8 + 4) = (f32x4){sum[4], sum[5], sum[6], sum[7]};
    __syncthreads();
    f32x4 h0 = (f32x4){0.f, 0.f, 0.f, 0.f}, h1 = h0;
    for (int cc = clo; cc < chi; ++cc) { h0 += *(const LAS f32x4*)(cs + cc * 68 + sg * 8); h1 += *(const LAS f32x4*)(cs + cc * 68 + sg * 8 + 4); }
    const float inv = 1.f / (float)((rhi - rlo) * (chi - clo));
    float o[8];
#pragma unroll
    for (int e = 0; e < 4; ++e) { o[e] = h0[e] * inv - own[e]; o[4 + e] = h1[e] * inv - own[4 + e]; }
    *(u32x4*)(Db + ((size_t)b * SL + r * 64 + c) * PWD + ch0) = pack8(o);
    __syncthreads();
}
__device__ __forceinline__ void scan_item(const bf16* AT, bf16* ST, float lgf2, float lgb2, int bh, int q, int tid) {
    const int e0 = q * 4096 + tid * 8; const bool dirb = ((tid & 15) >= 8);
    const float cd = ex2((dirb ? lgb2 : lgf2) * 128.f);
    const bf16* ab = AT + (size_t)bh * NPOS * 16384 + e0; bf16* sb = ST + (size_t)bh * NCH * 16384 + e0;
    float S[8];
#pragma unroll
    for (int e = 0; e < 8; ++e) S[e] = 0.f;
#pragma unroll
    for (int s = 0; s < NPOS; ++s) {
        if (s >= 2) { const int cc = dirb ? 17 - s : s - 2; *(u32x4*)(sb + (size_t)cc * 16384) = pack8(S); }
        if (s < NPOS - 1) { const int posr = dirb ? (s < 2 ? 1 - s : 19 - s) : s; float a[8]; unpack8(*(const u32x4*)(ab + (size_t)posr * 16384), a);
#pragma unroll
            for (int e = 0; e < 8; ++e) S[e] = cd * S[e] + a[e]; }
    }
}
__device__ __forceinline__ void r3_item(LAS unsigned char* lds, const bf16* Z, const bf16* ST, bf16* YN, const float* __restrict__ gnw, float lgf2, float lgb2,
                                         int b, int h, int c, int tid, int wave, int lane) {
    LAS unsigned char* Qs = lds; LAS unsigned char* Ks = lds + 18432; LAS unsigned char* Vt = lds + 36864; LAS unsigned char* Ps = lds + 71680; LAS unsigned char* Ss = lds + 106496;
    const size_t grow0 = (size_t)b * SL + c * 128;
    {
        const int row = tid >> 2, ds = tid & 3, d0 = ds * 8, tok = c * 128 + row;
        const bf16* zr = Z + (grow0 + row) * INW + h * DK + d0;
        float q1[8], q2[8], k1[8], k2[8];
        unpack8(*(const u32x4*)(zr + Q_OFF), q1); unpack8(*(const u32x4*)(zr + Q_OFF + 32), q2); unpack8(*(const u32x4*)(zr + K_OFF), k1); unpack8(*(const u32x4*)(zr + K_OFF + 32), k2);
        float qa[8], qb[8], ka[8], kb[8];
#pragma unroll
        for (int e = 0; e < 8; ++e) { float cs, sn; rope_cs(tok, d0 + e, cs, sn);
            qa[e] = q1[e] * cs - q2[e] * sn; qb[e] = q1[e] * sn + q2[e] * cs;
            ka[e] = (k1[e] * cs - k2[e] * sn) * 0.125f; kb[e] = (k1[e] * sn + k2[e] * cs) * 0.125f; }
        *(LAS u32x4*)(Qs + row * 144 + d0 * 2) = pack8(qa); *(LAS u32x4*)(Qs + row * 144 + (32 + d0) * 2) = pack8(qb);
        *(LAS u32x4*)(Ks + row * 144 + d0 * 2) = pack8(ka); *(LAS u32x4*)(Ks + row * 144 + (32 + d0) * 2) = pack8(kb);
    }
    stage_vt(Vt, Z + grow0 * INW + V_OFF + h * DV, INW, tid);
    {   const bf16* sp = ST + ((size_t)((b * NH + h) * NCH + c)) * 16384;
#pragma unroll
        for (int i = 0; i < 4; ++i) { const int idx = tid + NTHR * i, v = idx >> 4, seg = idx & 15; *(LAS u32x4*)(Ss + v * 272 + seg * 16) = *(const u32x4*)(sp + v * 128 + seg * 8); } }
    __syncthreads();
    const int fr = lane & 15, fq = lane >> 4, i0 = 16 * wave;
    f32x4 s[8];
#pragma unroll
    for (int ct = 0; ct < 8; ++ct) s[ct] = (f32x4){0.f, 0.f, 0.f, 0.f};
#pragma unroll
    for (int ks = 0; ks < 2; ++ks) {
        const bf16x8 a = *(const LAS bf16x8*)(Qs + (i0 + fr) * 144 + (32 * ks + 8 * fq) * 2);
#pragma unroll
        for (int ct = 0; ct < 8; ++ct) { const bf16x8 bb = *(const LAS bf16x8*)(Ks + (16 * ct + fr) * 144 + (32 * ks + 8 * fq) * 2); s[ct] = __builtin_amdgcn_mfma_f32_16x16x32_bf16(a, bb, s[ct], 0, 0, 0); }
    }
#pragma unroll
    for (int ct = 0; ct < 8; ++ct)
#pragma unroll
        for (int r = 0; r < 4; ++r) { const int i = i0 + 4 * fq + r, j = 16 * ct + fr, df = i - j;
            const float dv = ex2(df >= 0 ? lgf2 * (float)df : lgb2 * (float)(-df));
            *(LAS bf16*)(Ps + i * 272 + j * 2) = f2bf(s[ct][r] * dv); }
    __syncthreads();
    f32x4 o[8];
#pragma unroll
    for (int vt = 0; vt < 8; ++vt) o[vt] = (f32x4){0.f, 0.f, 0.f, 0.f};
#pragma unroll
    for (int ks = 0; ks < 4; ++ks) {
        const bf16x8 a = *(const LAS bf16x8*)(Ps + (i0 + fr) * 272 + (32 * ks + 8 * fq) * 2);
#pragma unroll
        for (int vt = 0; vt < 8; ++vt) { const bf16x8 bb = *(const LAS bf16x8*)(Vt + vt_off(16 * vt + fr, 32 * ks + 8 * fq)); o[vt] = __builtin_amdgcn_mfma_f32_16x16x32_bf16(a, bb, o[vt], 0, 0, 0); }
    }
    {   const int il = i0 + fr; const float dff = ex2(lgf2 * (float)(il + 1)), dbb = ex2(lgb2 * (float)(128 - il));
#pragma unroll
        for (int ks = 0; ks < 4; ++ks) {
            float qv[8]; unpack8(*(const LAS u32x4*)(Qs + il * 144 + (32 * (ks & 1) + 8 * fq) * 2), qv);
            const float dec = (ks < 2) ? dff : dbb;
#pragma unroll
            for (int e = 0; e < 8; ++e) qv[e] *= dec;
            const u32x4 pa = pack8(qv); const bf16x8 a = __builtin_bit_cast(bf16x8, pa);
#pragma unroll
            for (int vt = 0; vt < 8; ++vt) { const bf16x8 bb = *(const LAS bf16x8*)(Ss + (16 * vt + fr) * 272 + (32 * ks + 8 * fq) * 2); o[vt] = __builtin_amdgcn_mfma_f32_16x16x32_bf16(a, bb, o[vt], 0, 0, 0); }
        }
    }
    float gw_[8];
#pragma unroll
    for (int vt = 0; vt < 8; ++vt) gw_[vt] = gnw[h * DV + 16 * vt + fr];
#pragma unroll
    for (int r = 0; r < 4; ++r) {
        float sm = 0.f;
#pragma unroll
        for (int vt = 0; vt < 8; ++vt) sm += o[vt][r];
        sm += __shfl_xor(sm, 1); sm += __shfl_xor(sm, 2); sm += __shfl_xor(sm, 4); sm += __shfl_xor(sm, 8);
        const float mu = sm * (1.f / DV); float vs = 0.f;
#pragma unroll
        for (int vt = 0; vt < 8; ++vt) { const float d = o[vt][r] - mu; vs += d * d; }
        vs += __shfl_xor(vs, 1); vs += __shfl_xor(vs, 2); vs += __shfl_xor(vs, 4); vs += __shfl_xor(vs, 8);
        const float rstd = rsqrtf(vs * (1.f / DV) + EPS);
        const size_t row = grow0 + i0 + 4 * fq + r;
#pragma unroll
        for (int vt = 0; vt < 8; ++vt) { const int col = h * DV + 16 * vt + fr; const float gg = bf1(Z[row * INW + G_OFF + col]);
            YN[row * DM + col] = f2bf((o[vt][r] - mu) * rstd * gw_[vt] * silu_(gg)); }
    }
    __syncthreads();
}

struct Args { const float* in[21]; float* out; unsigned char* ws; int ph_lo, ph_hi; };
__global__ void __launch_bounds__(NTHR) mk_fwd(Args args) {
    extern __shared__ __attribute__((aligned(16))) unsigned char lds_raw[];
    LAS unsigned char* lds = (LAS unsigned char*)lds_raw;
    cg::grid_group grid = cg::this_grid();
    const int tid = threadIdx.x, lane = tid & 63, wave = __builtin_amdgcn_readfirstlane(tid >> 6);
    const int G = gridDim.x, bx = blockIdx.x, gw = bx * NWAVES + wave, NGW = G * NWAVES;
    const float* x = args.in[0]; const float* cnd = args.in[1]; const float* ctx = args.in[2]; const float* cctx = args.in[3];
    const float* w_ada = args.in[4]; const float* b_ada = args.in[5]; const float* norm_mix = args.in[6]; const float* norm_ffn = args.in[7];
    const float* w_in = args.in[8]; const float* w_pool = args.in[9]; const float* pscale = args.in[10]; const float* dec_f = args.in[11]; const float* dec_b = args.in[12];
    const float* gn_w = args.in[13]; const float* w_pa = args.in[14]; const float* w_rb = args.in[15]; const float* w_o = args.in[16];
    const float* w_ff1 = args.in[17]; const float* w_ff3 = args.in[18]; const float* w_ff2 = args.in[19]; const float* norm_final = args.in[20];
    float* out = args.out; unsigned char* ws = args.ws;
    bf16* W13T = (bf16*)(ws + WS_W13); bf16* W2T = (bf16*)(ws + WS_W2); bf16* WcT = (bf16*)(ws + WS_WCOMB); bf16* WrbT = (bf16*)(ws + WS_WRB); bf16* WoT = (bf16*)(ws + WS_WO);
    float* MODP = (float*)(ws + WS_MODP); float* MOD = (float*)(ws + WS_MOD);
    bf16* Z = (bf16*)(ws + WS_Z); bf16* WinT = (bf16*)(ws + WS_WIN); bf16* H = (bf16*)(ws + WS_H); bf16* HC = (bf16*)(ws + WS_HC); bf16* ZC = (bf16*)(ws + WS_ZC);
    bf16* Db = (bf16*)(ws + WS_D); bf16* ST = (bf16*)(ws + WS_ST); bf16* MG = (bf16*)(ws + WS_MERGED); bf16* H2 = (bf16*)(ws + WS_H2); bf16* HMID = (bf16*)(ws + WS_HMID);
    bf16* AT = (bf16*)out; bf16* YN = (bf16*)out;
    const int lo = args.ph_lo, hi = args.ph_hi;
#define IN(k) (lo <= (k) && (k) < hi)
#define SEAM(k) do { if (IN(k) && IN((k) + 1)) grid.sync(); } while (0)

    if (IN(0)) {
        LAS float* scr = (LAS float*)(lds + wave * 16384);
        constexpr int I_ADA = 96 * NKC, I_WC = 256, I_IN = (DM / 64) * (INW / 32), I_F1 = (DM / 64) * (DFF / 32), I_F2 = (DFF / 64) * (DM / 32), I_SQ = (DM / 64) * (DM / 32);
        constexpr int NIT = I_ADA + I_WC + I_IN + 2 * I_F1 + I_F2 + 2 * I_SQ;
        for (int it = gw; it < NIT; it += NGW) {
            int r = it;
            if (r < I_ADA) { ada_item(cnd, cctx, w_ada, MODP, r, lane); continue; } r -= I_ADA;
            if (r < I_WC) { wcomb_item(w_pool, pscale, w_pa, WcT, r, lane); continue; } r -= I_WC;
            if (r < I_IN) { transpose_item(w_in, DM, INW, WinT, 0, scr, r, lane); continue; } r -= I_IN;
            if (r < I_F1) { transpose_item(w_ff1, DM, DFF, W13T, 1, scr, r, lane); continue; } r -= I_F1;
            if (r < I_F1) { transpose_item(w_ff3, DM, DFF, W13T, 2, scr, r, lane); continue; } r -= I_F1;
            if (r < I_F2) { transpose_item(w_ff2, DFF, DM, W2T, 0, scr, r, lane); continue; } r -= I_F2;
            if (r < I_SQ) { transpose_item(w_rb, DM, DM, WrbT, 0, scr, r, lane); continue; } r -= I_SQ;
            transpose_item(w_o, DM, DM, WoT, 0, scr, r, lane);
        }
    }
    SEAM(0);
    if (IN(1)) {
        p1_norm(x, ctx, norm_mix, b_ada, MODP, H, HC, gw, NGW, lane);
        for (int i = bx * NTHR + tid; i < 9 * MODW; i += G * NTHR) { float s = b_ada[i % MODW];
#pragma unroll
            for (int kc = 0; kc < NKC; ++kc) s += MODP[(size_t)kc * 9 * MODW + i];
            MOD[i] = s; }
    }
    SEAM(1);
    if (IN(2)) {
        pg8::Gemm g{H, WinT, HC, WinT + (size_t)K_OFF * DM, DM}; pg8::StaticOrder S; S.init(MT, INW, G, bx, MCX, 1536);
        EpiZ E{Z, ZC};
        pg8::gemm_phase<EpiZ, pg8::StaticOrder, true, true>(lds, g, S, E);
    }
    SEAM(2);
    if (IN(3)) {
        constexpr int N_A = NB * NH * NPOS, N_P = NB * 4 * 32 * 2;
        for (int it = bx; it < N_A + N_P; it += G) {
            if (it < N_A) { const int bh = it / NPOS, pos = it % NPOS, b = bh >> 3, h = bh & 7;
                a_item(lds, Z, ZC, AT, log2_sigmoid(dec_f[h]), log2_sigmoid(dec_b[h]), b, h, pos, tid, wave, lane); }
            else { const int r_ = it - N_A, g = 3 - (r_ >> 9), rem = r_ & 511, b = rem >> 6, rr = (rem >> 1) & 31, chh = rem & 1;
                pool_item(lds, Z, Db, b, g, rr, chh, tid); }
        }
    }
    SEAM(3);
    if (IN(4)) {
        for (int it = bx; it < NB * NH * 4; it += G) { const int bh = it >> 2, q = it & 3, h = bh & 7;
            scan_item(AT, ST, log2_sigmoid(dec_f[h]), log2_sigmoid(dec_b[h]), bh, q, tid); }
    }
    SEAM(4);
    if (IN(5)) {
        for (int it = bx; it < NB * NH * NCH; it += G) { const int bh = it >> 4, c = it & 15, b = bh >> 3, h = bh & 7;
            r3_item(lds, Z, ST, YN, gn_w, log2_sigmoid(dec_f[h]), log2_sigmoid(dec_b[h]), b, h, c, tid, wave, lane); }
    }
    SEAM(5);
    if (IN(6)) {
        { pg8::Gemm g{Db, WcT, Db, WcT, PWD}; pg8::StaticOrder S; S.init(MT, DM, G, bx); EpiGate<false> E{Z, GA_OFF, MG};
          pg8::gemm_phase<EpiGate<false>, pg8::StaticOrder, true, true>(lds, g, S, E); }
        { pg8::Gemm g{YN, WrbT, YN, WrbT, DM}; pg8::StaticOrder S; S.init(MT, DM, G, bx); EpiGate<true> E{Z, GB_OFF, MG};
          pg8::gemm_phase<EpiGate<true>, pg8::StaticOrder, true, true>(lds, g, S, E); }
    }
    SEAM(6);
    if (IN(7)) {
        pg8::Gemm g{MG, WoT, MG, WoT, DM}; pg8::StaticOrder S; S.init(MT, DM, G, bx); EpiRes E{x, out, MOD, 2 * DM};
        pg8::gemm_phase<EpiRes, pg8::StaticOrder, true, true>(lds, g, S, E);
    }
    SEAM(7);
    if (IN(8)) p8_norm(out, norm_ffn, MOD, H2, gw, NGW, lane);
    SEAM(8);
    if (IN(9)) {
        pg8::Gemm g{H2, W13T, H2, W13T, DM}; pg8::StaticOrder S; S.init(MT, 2 * DFF, G, bx); EpiSwiglu E{HMID};
        pg8::gemm_phase<EpiSwiglu, pg8::StaticOrder, true, true>(lds, g, S, E);
    }
    SEAM(9);
    if (IN(10)) {
        pg8::Gemm g{HMID, W2T, HMID, W2T, DFF}; pg8::StaticOrder S; S.init(MT, DM, G, bx); EpiRes E{out, out, MOD, 5 * DM};
        pg8::gemm_phase<EpiRes, pg8::StaticOrder, true, true>(lds, g, S, E);
    }
    SEAM(10);
    if (IN(11)) p11_norm(out, norm_final, gw, NGW, lane);
#undef IN
#undef SEAM
}

extern "C" void kernel_launch(void* const* d_in, const int* in_sizes, int n_in, void* d_out, int out_size, void* d_ws, size_t ws_size, hipStream_t stream) {
    static int grid = 0;
    if (grid == 0) {
        if (n_in != 21 || out_size != MT * DM || ws_size < WS_END) { fprintf(stderr, "kernel_launch: unexpected problem (n_in %d, out %d, ws %zu)\n", n_in, out_size, ws_size); grid = -1; return; }
        int dev = 0, cus = 0, per_cu = 0;
        (void)hipGetDevice(&dev); (void)hipDeviceGetAttribute(&cus, hipDeviceAttributeMultiprocessorCount, dev);
        if (hipFuncSetAttribute((const void*)mk_fwd, hipFuncAttributeMaxDynamicSharedMemorySize, LDS_BYTES) != hipSuccess) { fprintf(stderr, "kernel_launch: hipFuncSetAttribute failed\n"); grid = -1; return; }
        if (hipOccupancyMaxActiveBlocksPerMultiprocessor(&per_cu, (const void*)mk_fwd, NTHR, LDS_BYTES) != hipSuccess || per_cu < 1) per_cu = 1;
        (void)hipGetLastError();
        if (cus <= 0) cus = 256;
        grid = cus * per_cu;
    }
    if (grid < 0) return;
    Args a{};
    for (int i = 0; i < 21; ++i) a.in[i] = (const float*)d_in[i];
    a.out = (float*)d_out; a.ws = (unsigned char*)d_ws;
#if MK_PER_PHASE
    for (int p = 0; p < NPHASE; ++p) { a.ph_lo = p; a.ph_hi = p + 1; hipLaunchKernelGGL(mk_fwd, dim3(grid), dim3(NTHR), LDS_BYTES, stream, a); }
#else
    a.ph_lo = 0; a.ph_hi = NPHASE;
    void* kargs[] = {(void*)&a};
    hipError_t e = hipLaunchCooperativeKernel((const void*)mk_fwd, dim3(grid), dim3(NTHR), kargs, LDS_BYTES, stream);
    if (e != hipSuccess) fprintf(stderr, "kernel_launch: cooperative launch failed: %s (grid %d)\n", hipGetErrorString(e), grid);
#endif
}
```

```cpp
#include <hip/hip_runtime.h>
#include <hip/hip_cooperative_groups.h>
#include <cstdio>
#include <cstdint>
namespace cg = cooperative_groups;

#ifndef MK_PER_PHASE
#define MK_PER_PHASE 0
#endif

namespace pg8 {
#define PG8_LAS __attribute__((address_space(3)))
typedef unsigned short bf16_t;
typedef short bf16x8 __attribute__((ext_vector_type(8)));
typedef float f32x4 __attribute__((ext_vector_type(4)));
typedef unsigned u32x4 __attribute__((ext_vector_type(4)));
constexpr int BM = 256, BK = 64, HALF = 128, HTB = HALF * BK * 2  , STAGE_BYTES = 8 * HTB, NXCD = 8, WGM = 8;

__host__ __device__ __forceinline__ int lds_byte(int r, int c) { const int st = (r >> 4) * 2 + (c >> 5), rr = r & 15, cc = c & 31, ob = rr * 64 + cc * 2; return st * 1024 + (ob ^ (((ob >> 9) & 1) << 5)); }
__host__ __device__ __forceinline__ void stage_rc(int b, int& R, int& C) { const int st = b / 1024, sb = b % 1024, swz = sb ^ (((sb >> 9) & 1) << 5); R = (st >> 1) * 16 + swz / 64; C = (st & 1) * 32 + (swz % 64) / 2; }
__host__ __device__ __forceinline__ int perm32(int rho) { const int n = rho >> 4, i = rho & 15; return 8 * (i >> 2) + 4 * n + (i & 3); }

struct Unit { int pm, pn, g; };
struct Gemm { const bf16_t* A; const bf16_t* Bt; const bf16_t* A2; const bf16_t* Bt2; int K;
    __device__ __forceinline__ const char* abase(const Unit& u) const { return (const char*)(u.g ? A2 : A) + (size_t)u.pm * (size_t)(2 * HALF) * K * 2; }
    __device__ __forceinline__ const char* bbase(const Unit& u) const { return (const char*)(u.g ? Bt2 : Bt) + (size_t)u.pn * (size_t)(2 * HALF) * K * 2; } };

struct StaticOrder {
    int nM, nN, nwg, G, c;
    int n2M, n2N;
    __host__ __device__ void init(int M, int N, int G_, int c_, int M2 = 0, int N2 = 0) { nM = M / BM; nN = N / BM; nwg = nM * nN; G = G_; c = c_; n2M = M2 / BM; n2N = N2 / BM; }
    __host__ __device__ bool next(int i, Unit& u) const {
        const long L = (long)i * G + c; u.g = 0;
        if (L >= nwg) { const long j = L - nwg; if (j >= (long)n2M * n2N) return false; u.g = 1; u.pm = (int)(j % n2M); u.pn = (int)(j / n2M); return true; }
        int wgid = (int)L; { const int q = nwg / NXCD, r = nwg % NXCD, xcd = wgid % NXCD, off = wgid / NXCD; wgid = (xcd < r ? xcd * (q + 1) : r * (q + 1) + (xcd - r) * q) + off; }
        const int nig = WGM * nN, gid = wgid / nig, fm = gid * WGM, gsz = (nM - fm) < WGM ? (nM - fm) : WGM;
        u.pm = fm + ((wgid % nig) % gsz); u.pn = (wgid % nig) / gsz; return true;
    }
    __device__ __forceinline__ void a_ready(const Unit&) const {}
    __device__ __forceinline__ void done(const Unit&) const {}
};

__device__ __forceinline__ unsigned cvt_pk_bf16(float lo, float hi) { unsigned r; asm volatile("v_cvt_pk_bf16_f32 %0, %1, %2" : "=v"(r) : "v"(lo), "v"(hi)); return r; }


template <class Epi, class Sched, bool ALIGN_EPI = false, bool SP2 = false>
__device__ __forceinline__ void gemm_phase(PG8_LAS unsigned char* lds, const Gemm g, const Sched& S, const Epi& E) {
    const int tid = threadIdx.x, wid = __builtin_amdgcn_readfirstlane(tid >> 6), lane = tid & 63, wr = wid >> 2, wc = wid & 3, fr = lane & 15, fq = lane >> 4;
    const int K = g.K, nt = K / BK;
    unsigned voffA[2], voffB[2];
#pragma unroll
    for (int i = 0; i < 2; ++i) { int R, C; stage_rc(tid * 16 + i * 8192, R, C); const int Rb = Epi::PERM ? ((R & ~31) + perm32(R & 31)) : R;
        voffA[i] = (unsigned)(R * K + C) * 2u; voffB[i] = (unsigned)(Rb * K + C) * 2u; }
    const size_t kstep = (size_t)(BK * 2);
    const size_t hstep = (size_t)HALF * K * 2;
    const unsigned ldsw = (unsigned)wid * 1024u;
    const int aoff = lds_byte(wr * 64 + fr, fq * 8), boff = lds_byte(wc * 32 + fr, fq * 8);
#define PG8_SA(b, h) (((b) * 2 + (h)) * HTB)
#define PG8_SB(b, h) ((4 + (b) * 2 + (h)) * HTB)
#define PG8_STAGE(bufoff, gbase, voff) do { _Pragma("unroll") for (int _i = 0; _i < 2; ++_i) \
        __builtin_amdgcn_global_load_lds((const unsigned*)((const char*)(gbase) + (voff)[_i]), (PG8_LAS unsigned*)(lds + (bufoff) + ldsw + _i * 8192), 16, 0, 0); } while (0)
#define PG8_LDA(dst, b, h) do { _Pragma("unroll") for (int m = 0; m < 4; ++m) _Pragma("unroll") for (int k = 0; k < 2; ++k) dst[m][k] = *(const PG8_LAS bf16x8*)(lds + PG8_SA(b, h) + aoff + m * 2048 + k * 1024); } while (0)
#define PG8_LDB(dst, b, h) do { _Pragma("unroll") for (int n = 0; n < 2; ++n) _Pragma("unroll") for (int k = 0; k < 2; ++k) dst[n][k] = *(const PG8_LAS bf16x8*)(lds + PG8_SB(b, h) + boff + n * 2048 + k * 1024); } while (0)
#define PG8_MMA(ai, bj, At, Bt) do { __builtin_amdgcn_s_setprio(1); _Pragma("unroll") for (int m = 0; m < 4; ++m) _Pragma("unroll") for (int n = 0; n < 2; ++n) _Pragma("unroll") for (int k = 0; k < 2; ++k) \
        acc[ai][bj][m][n] = __builtin_amdgcn_mfma_f32_16x16x32_bf16(Bt[n][k], At[m][k], acc[ai][bj][m][n], 0, 0, 0); __builtin_amdgcn_s_setprio(0); } while (0)
#define PG8_WAIT_V(n) asm volatile("s_waitcnt vmcnt(" #n ")" ::: "memory")
#define PG8_WAIT_L(n) asm volatile("s_waitcnt lgkmcnt(" #n ")" ::: "memory")
#define PG8_BAR __builtin_amdgcn_s_barrier()
#define PG8_SCHED __builtin_amdgcn_sched_barrier(0)
    Unit cur, nxt; int ui = 0;
    if (!S.next(0, cur)) return;
    f32x4 acc[2][2][4][2];
#pragma unroll
    for (int a = 0; a < 2; ++a)
#pragma unroll
        for (int b = 0; b < 2; ++b)
#pragma unroll
            for (int m = 0; m < 4; ++m)
#pragma unroll
                for (int n = 0; n < 2; ++n) acc[a][b][m][n] = (f32x4){0.f, 0.f, 0.f, 0.f};
    bf16x8 At[4][2], B0[2][2], B1[2][2];
    const char* cA = g.abase(cur); const char* cB = g.bbase(cur);
    S.a_ready(cur);
    if constexpr (SP2) {
        PG8_STAGE(PG8_SB(0, 0), cB, voffB); PG8_STAGE(PG8_SB(0, 1), cB + hstep, voffB); PG8_STAGE(PG8_SA(0, 0), cA, voffA); PG8_STAGE(PG8_SA(0, 1), cA + hstep, voffA);
        if (wr == 1) PG8_BAR;
        PG8_WAIT_V(2); PG8_BAR;
        PG8_STAGE(PG8_SB(1, 0), cB + kstep, voffB); PG8_STAGE(PG8_SA(1, 0), cA + kstep, voffA); PG8_STAGE(PG8_SB(1, 1), cB + hstep + kstep, voffB);
        PG8_WAIT_V(6); PG8_BAR;
    } else {
        PG8_STAGE(PG8_SB(0, 0), cB, voffB); PG8_STAGE(PG8_SA(0, 0), cA, voffA); PG8_STAGE(PG8_SB(0, 1), cB + hstep, voffB); PG8_STAGE(PG8_SA(0, 1), cA + hstep, voffA);
        if (wr == 1) PG8_BAR;
        PG8_WAIT_V(4); PG8_BAR;
        PG8_STAGE(PG8_SB(1, 0), cB + kstep, voffB); PG8_STAGE(PG8_SA(1, 0), cA + kstep, voffA); PG8_STAGE(PG8_SB(1, 1), cB + hstep + kstep, voffB);
        PG8_WAIT_V(6); PG8_BAR;
    }
    for (;;) {
        const bool has_next = S.next(ui + 1, nxt);
        const char* nA = has_next ? g.abase(nxt) : cA; const char* nB = has_next ? g.bbase(nxt) : cB;
        for (int t = 0; t < nt; t += 2) {
            const bool last = (t == nt - 2);
            const char* a1 = cA + (size_t)(t + 1) * kstep;
            const char* a2 = last ? nA : cA + (size_t)(t + 2) * kstep; const char* b2 = last ? nB : cB + (size_t)(t + 2) * kstep;
            const char* a3 = a2 + kstep; const char* b3 = b2 + kstep;
            if (last && has_next) S.a_ready(nxt);
            if constexpr (SP2) {
            PG8_LDB(B0, 0, 0); PG8_LDB(B1, 0, 1); PG8_SCHED; PG8_LDA(At, 0, 0); PG8_STAGE(PG8_SA(1, 1), a1 + hstep, voffA);
            PG8_WAIT_V(8); PG8_WAIT_L(0); PG8_BAR; PG8_MMA(0, 0, At, B0); PG8_MMA(0, 1, At, B1); PG8_BAR; PG8_SCHED;
            PG8_LDA(At, 0, 1); PG8_STAGE(PG8_SB(0, 0), b2, voffB); PG8_STAGE(PG8_SB(0, 1), b2 + hstep, voffB); PG8_STAGE(PG8_SA(0, 0), a2, voffA);
            PG8_WAIT_V(8); PG8_WAIT_L(0); PG8_BAR; PG8_MMA(1, 0, At, B0); PG8_MMA(1, 1, At, B1); PG8_BAR; PG8_SCHED;
            PG8_LDB(B0, 1, 0); PG8_LDB(B1, 1, 1); PG8_SCHED; PG8_LDA(At, 1, 0); PG8_STAGE(PG8_SA(0, 1), a2 + hstep, voffA);
            PG8_WAIT_V(8); PG8_WAIT_L(0); PG8_BAR; PG8_MMA(0, 0, At, B0); PG8_MMA(0, 1, At, B1); PG8_BAR; PG8_SCHED;
            PG8_LDA(At, 1, 1); PG8_STAGE(PG8_SB(1, 0), b3, voffB); PG8_STAGE(PG8_SB(1, 1), b3 + hstep, voffB); PG8_STAGE(PG8_SA(1, 0), a3, voffA);
            PG8_WAIT_V(8); PG8_WAIT_L(0); PG8_BAR; PG8_MMA(1, 0, At, B0); PG8_MMA(1, 1, At, B1); PG8_BAR; PG8_SCHED;
            } else {
            PG8_LDB(B0, 0, 0); PG8_SCHED; PG8_LDA(At, 0, 0); PG8_STAGE(PG8_SA(1, 1), a1 + hstep, voffA);
            PG8_WAIT_L(8); PG8_BAR; PG8_WAIT_L(0); PG8_MMA(0, 0, At, B0); PG8_BAR; PG8_SCHED;
            PG8_LDB(B1, 0, 1); PG8_STAGE(PG8_SB(0, 0), b2, voffB);
            PG8_BAR; PG8_WAIT_L(0); PG8_MMA(0, 1, At, B1); PG8_BAR;
            PG8_LDA(At, 0, 1); PG8_STAGE(PG8_SA(0, 0), a2, voffA);
            PG8_BAR; PG8_WAIT_L(0); PG8_MMA(1, 0, At, B0); PG8_BAR; PG8_SCHED;
            PG8_STAGE(PG8_SB(0, 1), b2 + hstep, voffB);
            PG8_WAIT_V(6); PG8_BAR; PG8_MMA(1, 1, At, B1); PG8_BAR;
            PG8_LDB(B0, 1, 0); PG8_SCHED; PG8_LDA(At, 1, 0); PG8_STAGE(PG8_SA(0, 1), a2 + hstep, voffA);
            PG8_WAIT_L(8); PG8_BAR; PG8_WAIT_L(0); PG8_MMA(0, 0, At, B0); PG8_BAR; PG8_SCHED;
            PG8_LDB(B1, 1, 1); PG8_STAGE(PG8_SB(1, 0), b3, voffB);
            PG8_BAR; PG8_WAIT_L(0); PG8_MMA(0, 1, At, B1); PG8_BAR;
            PG8_LDA(At, 1, 1); PG8_STAGE(PG8_SA(1, 0), a3, voffA);
            PG8_BAR; PG8_WAIT_L(0); PG8_MMA(1, 0, At, B0); PG8_BAR; PG8_SCHED;
            PG8_STAGE(PG8_SB(1, 1), b3 + hstep, voffB);
            PG8_WAIT_V(6); PG8_BAR; PG8_MMA(1, 1, At, B1); PG8_BAR;
            }
        }
        if constexpr (ALIGN_EPI) { if (wr == 0) PG8_BAR; }
        if constexpr (!Epi::AFTER_DRAIN) { E(acc, cur, wr, wc, fr, fq); S.done(cur); }
        if (!has_next) break;
#pragma unroll
        for (int a = 0; a < 2; ++a)
#pragma unroll
            for (int b = 0; b < 2; ++b)
#pragma unroll
                for (int m = 0; m < 4; ++m)
#pragma unroll
                    for (int n = 0; n < 2; ++n) acc[a][b][m][n] = (f32x4){0.f, 0.f, 0.f, 0.f};
        cur = nxt; cA = nA; cB = nB; ++ui;
        if constexpr (ALIGN_EPI) { if (wr == 1) PG8_BAR; }
    }
    PG8_WAIT_V(0);
    if constexpr (!ALIGN_EPI) { if (wr == 0) PG8_BAR; }
    PG8_BAR;
    if constexpr (Epi::AFTER_DRAIN) { E.fused(acc, cur, wr, wc, fr, fq, lds, wid, lane); S.done(cur); }
#undef PG8_SA
#undef PG8_SB
#undef PG8_STAGE
#undef PG8_LDA
#undef PG8_LDB
#undef PG8_MMA
#undef PG8_WAIT_V
#undef PG8_WAIT_L
#undef PG8_BAR
#undef PG8_SCHED
}
}

using pg8::f32x4; using pg8::bf16x8; using pg8::u32x4; using pg8::Unit;
#define LAS __attribute__((address_space(3)))
typedef unsigned short bf16;
typedef unsigned u32x2 __attribute__((ext_vector_type(2)));
typedef float f32x2_t __attribute__((ext_vector_type(2)));
typedef __bf16 bf16x2_t __attribute__((ext_vector_type(2)));
#define LDS_WAIT() asm volatile("s_waitcnt lgkmcnt(0)" ::: "memory")

constexpr int NWAVES = 8, NTHR = 512;
constexpr int DM = 1024, NB = 8, SL = 2048, MT = NB * SL, LCX = 256, MCX = NB * LCX;
constexpr int INW = 5632, DFF = 2816, PWD = 512, NH = 8, DK = 64, DV = 128;
constexpr int Q_OFF = 512, K_OFF = 1024, V_OFF = 1536, G_OFF = 2560, GA_OFF = 3584, GB_OFF = 4608;
constexpr int NPOS = 18, NCH = 16, MODW = 6 * DM, NKC = 4;
constexpr float EPS = 1e-6f, LOG2E = 1.4426950408889634f;
constexpr int LDS_BYTES = 147456;
constexpr int NPHASE = 12;
#ifndef MK_REPS
#define MK_REPS {1,1,1,1,1,1,1,1,1,1,1,1}
#endif
__device__ constexpr int REPS[NPHASE] = MK_REPS;

constexpr size_t MiB = 1u << 20;
constexpr size_t WS_W13 = 1 * MiB, WS_W2 = 12 * MiB, WS_WCOMB = 17 * MiB + MiB / 2, WS_WRB = 18 * MiB + MiB / 2, WS_WO = 20 * MiB + MiB / 2;
constexpr size_t WS_MODP = 22 * MiB + MiB / 2, WS_MOD = 23 * MiB + MiB / 2, WS_Z = 24 * MiB, WS_SA = 200 * MiB, WS_END = 256 * MiB;
constexpr size_t WS_WIN = WS_SA, WS_H = WS_SA + 11 * MiB, WS_HC = WS_SA + 43 * MiB, WS_ZC = WS_SA + 47 * MiB;
constexpr size_t WS_D = WS_SA, WS_ST = WS_SA + 16 * MiB, WS_MERGED = WS_SA + 16 * MiB, WS_H2 = WS_SA, WS_HMID = WS_Z;
static_assert(WS_ZC + (size_t)MCX * 1536 * 2 <= WS_END && WS_ST + (size_t)64 * 16 * 16384 * 2 <= WS_END && WS_Z + (size_t)MT * INW * 2 <= WS_SA, "ws map");
static_assert((size_t)NKC * 9 * MODW * 4 <= MiB && (size_t)64 * NPOS * 16384 * 2 <= (size_t)MT * DM * 4, "ws map 2");

__device__ __forceinline__ unsigned pk2(float lo, float hi) { f32x2_t v = {lo, hi}; bf16x2_t b = __builtin_convertvector(v, bf16x2_t); return __builtin_bit_cast(unsigned, b); }
__device__ __forceinline__ bf16 f2bf(float f) { return (bf16)(pk2(f, 0.f) & 0xffffu); }
__device__ __forceinline__ float bflo(unsigned u) { return __uint_as_float(u << 16); }
__device__ __forceinline__ float bfhi(unsigned u) { return __uint_as_float(u & 0xffff0000u); }
__device__ __forceinline__ float bf1(bf16 v) { return __uint_as_float((unsigned)v << 16); }
__device__ __forceinline__ float wave_sum(float v) {
#pragma unroll
    for (int o = 1; o < 64; o <<= 1) v += __shfl_xor(v, o);
    return v;
}
__device__ __forceinline__ float sigmoid_(float x) { return __builtin_amdgcn_rcpf(1.f + __builtin_amdgcn_exp2f(-x * LOG2E)); }
__device__ __forceinline__ float silu_(float x) { return x * sigmoid_(x); }
__device__ __forceinline__ float ex2(float x) { return __builtin_amdgcn_exp2f(x); }
__device__ __forceinline__ float log2_sigmoid(float x) { return -log1pf(expf(-x)) * LOG2E; }
__device__ __forceinline__ void unpack8(const u32x4 r, float (&f)[8]) {
    f[0] = bflo(r.x); f[1] = bfhi(r.x); f[2] = bflo(r.y); f[3] = bfhi(r.y); f[4] = bflo(r.z); f[5] = bfhi(r.z); f[6] = bflo(r.w); f[7] = bfhi(r.w);
}
__device__ __forceinline__ u32x4 pack8(const float (&f)[8]) { u32x4 o; o.x = pk2(f[0], f[1]); o.y = pk2(f[2], f[3]); o.z = pk2(f[4], f[5]); o.w = pk2(f[6], f[7]); return o; }

struct EpiZ {
    static constexpr bool PERM = true, AFTER_DRAIN = false;
    bf16* Z; bf16* ZC;
    __device__ __forceinline__ void operator()(const f32x4 (&acc)[2][2][4][2], const Unit& u, int wr, int wc, int fr, int fq) const {
        bf16* base = u.g ? ZC : Z; const int ldc = u.g ? 1536 : INW; const bool sig = (u.g == 0) && (u.pn >= GA_OFF / 256);
        const int row0 = u.pm * 256 + wr * 64 + fr, col0 = u.pn * 256 + wc * 32 + 8 * fq;
#pragma unroll
        for (int ai = 0; ai < 2; ++ai)
#pragma unroll
            for (int m = 0; m < 4; ++m) { bf16* rowp = base + (size_t)(row0 + ai * 128 + m * 16) * ldc + col0;
#pragma unroll
                for (int bj = 0; bj < 2; ++bj) { f32x4 v0 = acc[ai][bj][m][0], v1 = acc[ai][bj][m][1];
                    if (sig) {
#pragma unroll
                        for (int e = 0; e < 4; ++e) { v0[e] = sigmoid_(v0[e]); v1[e] = sigmoid_(v1[e]); } }
                    u32x4 w; w.x = pk2(v0[0], v0[1]); w.y = pk2(v0[2], v0[3]); w.z = pk2(v1[0], v1[1]); w.w = pk2(v1[2], v1[3]);
                    *(u32x4*)(rowp + bj * 128) = w; } }
    }
};
template <bool ADD> struct EpiGate {
    static constexpr bool PERM = true, AFTER_DRAIN = false;
    const bf16* Z; int goff; bf16* O;
    __device__ __forceinline__ void operator()(const f32x4 (&acc)[2][2][4][2], const Unit& u, int wr, int wc, int fr, int fq) const {
        const int row0 = u.pm * 256 + wr * 64 + fr, col0 = u.pn * 256 + wc * 32 + 8 * fq;
#pragma unroll
        for (int ai = 0; ai < 2; ++ai)
#pragma unroll
            for (int m = 0; m < 4; ++m) { const size_t row = (size_t)(row0 + ai * 128 + m * 16);
#pragma unroll
                for (int bj = 0; bj < 2; ++bj) { const int col = col0 + bj * 128;
                    float gt[8], o[8]; unpack8(*(const u32x4*)(Z + row * INW + goff + col), gt);
                    if (ADD) unpack8(*(const u32x4*)(O + row * DM + col), o);
#pragma unroll
                    for (int e = 0; e < 8; ++e) { const float a = acc[ai][bj][m][e >> 2][e & 3]; o[e] = ADD ? (o[e] + gt[e] * a) : (gt[e] * a); }
                    *(u32x4*)(O + row * DM + col) = pack8(o); } }
    }
};
struct EpiRes {
    static constexpr bool PERM = true, AFTER_DRAIN = false;
    const float* base; float* out; const float* mod; int goff;
    __device__ __forceinline__ void operator()(const f32x4 (&acc)[2][2][4][2], const Unit& u, int wr, int wc, int fr, int fq) const {
        const int row0 = u.pm * 256 + wr * 64 + fr, col0 = u.pn * 256 + wc * 32 + 8 * fq, b = u.pm >> 3;
        const float* gp = mod + (size_t)b * MODW + goff + col0;
        f32x4 gv[2][2];
#pragma unroll
        for (int bj = 0; bj < 2; ++bj)
#pragma unroll
            for (int n = 0; n < 2; ++n) gv[bj][n] = *(const f32x4*)(gp + bj * 128 + 4 * n);
#pragma unroll
        for (int ai = 0; ai < 2; ++ai)
#pragma unroll
            for (int m = 0; m < 4; ++m) { const size_t ro = (size_t)(row0 + ai * 128 + m * 16) * DM + col0;
#pragma unroll
                for (int bj = 0; bj < 2; ++bj)
#pragma unroll
                    for (int n = 0; n < 2; ++n) { const f32x4 bv = *(const f32x4*)(base + ro + bj * 128 + 4 * n);
                        *(f32x4*)(out + ro + bj * 128 + 4 * n) = bv + gv[bj][n] * acc[ai][bj][m][n]; } }
    }
};
struct EpiSwiglu {
    static constexpr bool PERM = true, AFTER_DRAIN = false;
    bf16* O;
    __device__ __forceinline__ void operator()(const f32x4 (&acc)[2][2][4][2], const Unit& u, int wr, int wc, int fr, int fq) const {
        const int row0 = u.pm * 256 + wr * 64 + fr, col0 = u.pn * 128 + wc * 32 + 8 * fq;
#pragma unroll
        for (int ai = 0; ai < 2; ++ai)
#pragma unroll
            for (int m = 0; m < 4; ++m) { float o[8];
#pragma unroll
                for (int e = 0; e < 8; ++e) o[e] = silu_(acc[ai][0][m][e >> 2][e & 3]) * acc[ai][1][m][e >> 2][e & 3];
                *(u32x4*)(O + (size_t)(row0 + ai * 128 + m * 16) * DFF + col0) = pack8(o); }
    }
};

__device__ __forceinline__ void transpose_item(const float* __restrict__ W, int K, int N, bf16* WT, int mode, LAS float* scr, int item, int lane) {
    const int nblk = N / 32, kb = item / nblk, nb = item % nblk, k0 = 64 * kb, n0 = 32 * nb;
#pragma unroll 8
    for (int i = 0; i < 32; ++i) { const int kk = 2 * i + (lane >> 5); scr[kk * 33 + (lane & 31)] = W[(size_t)(k0 + kk) * N + n0 + (lane & 31)]; }
    LDS_WAIT(); asm volatile("" ::: "memory");
    const int c = lane & 7;
    const int drow0 = (mode == 0) ? n0 : (256 * (n0 >> 7) + (n0 & 127) + (mode == 2 ? 128 : 0));
#pragma unroll
    for (int j = 0; j < 4; ++j) { const int n = (lane >> 3) + 8 * j; const LAS float* s = scr + (8 * c) * 33 + n;
        u32x4 o; o.x = pk2(s[0 * 33], s[1 * 33]); o.y = pk2(s[2 * 33], s[3 * 33]); o.z = pk2(s[4 * 33], s[5 * 33]); o.w = pk2(s[6 * 33], s[7 * 33]);
        *(u32x4*)(WT + (size_t)(drow0 + n) * K + k0 + 8 * c) = o; }
    LDS_WAIT(); asm volatile("" ::: "memory");
}
__device__ __forceinline__ void wcomb_item(const float* __restrict__ w_pool, const float* __restrict__ pscale, const float* __restrict__ w_pa, bf16* WcT, int item, int lane) {
    const int g = item >> 6, n0 = (item & 63) * 16;
    float a0[16], a1[16];
#pragma unroll
    for (int n = 0; n < 16; ++n) { a0[n] = 0.f; a1[n] = 0.f; }
    const float* p0 = w_pool + ((size_t)(g * 128 + lane)) * 128; const float* p1 = p0 + 64 * 128;
    for (int d4 = 0; d4 < 32; ++d4) {
        const f32x4 x0 = *(const f32x4*)(p0 + 4 * d4), x1 = *(const f32x4*)(p1 + 4 * d4);
#pragma unroll
        for (int dd = 0; dd < 4; ++dd) { const int d = g * 128 + 4 * d4 + dd; const float ps = pscale[d]; const float* wp = w_pa + (size_t)d * DM + n0;
#pragma unroll
            for (int n = 0; n < 16; ++n) { const float bb = wp[n] * ps; a0[n] += x0[dd] * bb; a1[n] += x1[dd] * bb; } }
    }
#pragma unroll
    for (int n = 0; n < 16; ++n) { WcT[(size_t)(n0 + n) * PWD + g * 128 + lane] = f2bf(a0[n]); WcT[(size_t)(n0 + n) * PWD + g * 128 + 64 + lane] = f2bf(a1[n]); }
}
__device__ __forceinline__ void ada_item(const float* __restrict__ cnd, const float* __restrict__ cctx, const float* __restrict__ w_ada, float* MODP, int item, int lane) {
    const int cb = item % 96, kc = item / 96, col = cb * 64 + lane;
    float acc[9];
#pragma unroll
    for (int b = 0; b < 9; ++b) acc[b] = 0.f;
    for (int sub = 0; sub < 4; ++sub) {
        const int kb = kc * 256 + sub * 64;
        float sv[9];
#pragma unroll
        for (int b = 0; b < 9; ++b) { const float x = (b < 8) ? cnd[b * DM + kb + lane] : cctx[kb + lane]; sv[b] = x / (1.f + expf(-x)); }
        const float* wp = w_ada + (size_t)kb * MODW + col;
#pragma unroll
        for (int kk = 0; kk < 64; ++kk) { const float w = wp[(size_t)kk * MODW];
#pragma unroll
            for (int b = 0; b < 9; ++b) acc[b] += __int_as_float(__builtin_amdgcn_readlane(__float_as_int(sv[b]), kk)) * w; }
    }
#pragma unroll
    for (int b = 0; b < 9; ++b) MODP[((size_t)kc * 9 + b) * MODW + col] = acc[b];
}

__device__ __forceinline__ void p1_norm(const float* __restrict__ x, const float* __restrict__ ctx, const float* __restrict__ gain, const float* __restrict__ b_ada, const float* MODP,
                                         bf16* H, bf16* HC, int gw, int NGW, int lane) {
    const int total = MT + MCX, per = (total + NGW - 1) / NGW, r0 = gw * per, r1 = (r0 + per < total) ? r0 + per : total;
    int curb = -1; f32x4 gs[4], sh[4];
    for (int r = r0; r < r1; ++r) {
        const int b = (r < MT) ? (r >> 11) : 8;
        if (b != curb) { curb = b;
#pragma unroll
            for (int j = 0; j < 4; ++j) { const int col = 4 * lane + 256 * j;
                f32x4 s = *(const f32x4*)(b_ada + col), c = *(const f32x4*)(b_ada + DM + col);
#pragma unroll
                for (int kc = 0; kc < NKC; ++kc) { s += *(const f32x4*)(MODP + ((size_t)kc * 9 + b) * MODW + col); c += *(const f32x4*)(MODP + ((size_t)kc * 9 + b) * MODW + DM + col); }
                const f32x4 g = *(const f32x4*)(gain + col);
                sh[j] = s; gs[j] = g * (c + 1.0f); } }
        const float* src = (r < MT) ? x + (size_t)r * DM : ctx + (size_t)(r - MT) * DM;
        bf16* dst = (r < MT) ? H + (size_t)r * DM : HC + (size_t)(r - MT) * DM;
        f32x4 v[4]; float ss = 0.f;
#pragma unroll
        for (int j = 0; j < 4; ++j) { v[j] = *(const f32x4*)(src + 4 * lane + 256 * j); ss += (v[j].x * v[j].x + v[j].y * v[j].y) + (v[j].z * v[j].z + v[j].w * v[j].w); }
        const float rstd = rsqrtf(wave_sum(ss) * (1.f / DM) + EPS);
#pragma unroll
        for (int j = 0; j < 4; ++j) { const f32x4 o = v[j] * rstd * gs[j] + sh[j]; u32x2 w; w.x = pk2(o.x, o.y); w.y = pk2(o.z, o.w); *(u32x2*)(dst + 4 * lane + 256 * j) = w; }
    }
}
__device__ __forceinline__ void p8_norm(const float* x1, const float* __restrict__ gain, const float* MOD, bf16* H2, int gw, int NGW, int lane) {
    const int per = (MT + NGW - 1) / NGW, r0 = gw * per, r1 = (r0 + per < MT) ? r0 + per : MT;
    int curb = -1; f32x4 gs[4], sh[4];
    for (int r = r0; r < r1; ++r) {
        const int b = r >> 11;
        if (b != curb) { curb = b;
#pragma unroll
            for (int j = 0; j < 4; ++j) { const int col = 4 * lane + 256 * j;
                const f32x4 s = *(const f32x4*)(MOD + (size_t)b * MODW + 3 * DM + col), c = *(const f32x4*)(MOD + (size_t)b * MODW + 4 * DM + col), g = *(const f32x4*)(gain + col);
                sh[j] = s; gs[j] = g * (c + 1.0f); } }
        const float* src = x1 + (size_t)r * DM; bf16* dst = H2 + (size_t)r * DM;
        f32x4 v[4]; float ss = 0.f;
#pragma unroll
        for (int j = 0; j < 4; ++j) { v[j] = *(const f32x4*)(src + 4 * lane + 256 * j); ss += (v[j].x * v[j].x + v[j].y * v[j].y) + (v[j].z * v[j].z + v[j].w * v[j].w); }
        const float rstd = rsqrtf(wave_sum(ss) * (1.f / DM) + EPS);
#pragma unroll
        for (int j = 0; j < 4; ++j) { const f32x4 o = v[j] * rstd * gs[j] + sh[j]; u32x2 w; w.x = pk2(o.x, o.y); w.y = pk2(o.z, o.w); *(u32x2*)(dst + 4 * lane + 256 * j) = w; }
    }
}
__device__ __forceinline__ void p11_norm(float* out, const float* __restrict__ gain, int gw, int NGW, int lane) {
    f32x4 g[4];
#pragma unroll
    for (int j = 0; j < 4; ++j) g[j] = *(const f32x4*)(gain + 4 * lane + 256 * j);
    for (int r = gw; r < MT; r += NGW) {
        float* p = out + (size_t)r * DM;
        f32x4 v[4]; float ss = 0.f;
#pragma unroll
        for (int j = 0; j < 4; ++j) { v[j] = *(const f32x4*)(p + 4 * lane + 256 * j); ss += (v[j].x * v[j].x + v[j].y * v[j].y) + (v[j].z * v[j].z + v[j].w * v[j].w); }
        const float rstd = rsqrtf(wave_sum(ss) * (1.f / DM) + EPS);
#pragma unroll
        for (int j = 0; j < 4; ++j) *(f32x4*)(p + 4 * lane + 256 * j) = v[j] * rstd * g[j];
    }
}

__device__ __forceinline__ int vt_off(int v, int j) { return v * 272 + ((((j >> 3) ^ (v >> 3)) & 15) << 4) + (j & 7) * 2; }
__device__ __forceinline__ void stage_vt(LAS unsigned char* vt, const bf16* vbase, int ld, int tid) {
    const int vseg = tid & 15, j0 = (tid >> 4) * 4;
    u32x4 r[4];
#pragma unroll
    for (int jj = 0; jj < 4; ++jj) r[jj] = *(const u32x4*)(vbase + (size_t)(j0 + jj) * ld + vseg * 8);
#pragma unroll
    for (int e2 = 0; e2 < 4; ++e2) {
        const unsigned a0 = r[0][e2], a1 = r[1][e2], a2 = r[2][e2], a3 = r[3][e2];
        u32x2 lo, hi; lo.x = (a0 & 0xffffu) | (a1 << 16); lo.y = (a2 & 0xffffu) | (a3 << 16); hi.x = (a0 >> 16) | (a1 & 0xffff0000u); hi.y = (a2 >> 16) | (a3 & 0xffff0000u);
        const int v = vseg * 8 + 2 * e2;
        *(LAS u32x2*)(vt + vt_off(v, j0)) = lo; *(LAS u32x2*)(vt + vt_off(v + 1, j0)) = hi;
    }
}
__device__ __forceinline__ void rope_cs(int tok, int f, float& cs, float& sn) {
    const float pos = (float)((f < 16) ? (tok >> 6) : (tok & 63));
    const float ang = pos * ex2(-(float)(f & 15) * 0.8304820237218406f);
    cs = __cosf(ang); sn = __sinf(ang);
}
__device__ __forceinline__ void a_item(LAS unsigned char* lds, const bf16* Z, const bf16* ZC, bf16* AT, float lgf2, float lgb2, int b, int h, int pos, int tid, int wave, int lane) {
    LAS unsigned char* Vt = lds; LAS unsigned char* Kt = lds + 34816;
    const bool lat = pos >= 2; const int c = pos - 2;
    const bf16* kbase = lat ? Z + ((size_t)b * SL + c * 128) * INW + K_OFF + h * DK : ZC + ((size_t)b * LCX + pos * 128) * 1536 + h * DK;
    const bf16* vbase = lat ? Z + ((size_t)b * SL + c * 128) * INW + V_OFF + h * DV : ZC + ((size_t)b * LCX + pos * 128) * 1536 + 512 + h * DV;
    const int ld = lat ? INW : 1536;
    stage_vt(Vt, vbase, ld, tid);
    if (tid < 256) {
        const int tt = tid & 127, dir = tid >> 7, ds = tt & 3, j0 = (tt >> 2) * 4, d0 = ds * 8;
        const float lg2 = dir ? lgb2 : lgf2;
        unsigned p1[8][2], p2[8][2];
#pragma unroll
        for (int jp = 0; jp < 2; ++jp) {
            float o1[2][8], o2[2][8];
#pragma unroll
            for (int q = 0; q < 2; ++q) { const int j = j0 + 2 * jp + q;
                float x1[8], x2[8]; unpack8(*(const u32x4*)(kbase + (size_t)j * ld + d0), x1); unpack8(*(const u32x4*)(kbase + (size_t)j * ld + 32 + d0), x2);
                const float dec = ex2(lg2 * (float)(dir ? j : 127 - j)) * 0.125f;
#pragma unroll
                for (int e = 0; e < 8; ++e) {
                    float a = x1[e], bb = x2[e];
                    if (lat) { float cs, sn; rope_cs(c * 128 + j, d0 + e, cs, sn); const float t1 = a * cs - bb * sn, t2 = a * sn + bb * cs; a = t1; bb = t2; }
                    o1[q][e] = a * dec; o2[q][e] = bb * dec; } }
#pragma unroll
            for (int e = 0; e < 8; ++e) { p1[e][jp] = pk2(o1[0][e], o1[1][e]); p2[e][jp] = pk2(o2[0][e], o2[1][e]); }
        }
#pragma unroll
        for (int e = 0; e < 8; ++e) { u32x2 w1, w2; w1.x = p1[e][0]; w1.y = p1[e][1]; w2.x = p2[e][0]; w2.y = p2[e][1];
            *(LAS u32x2*)(Kt + vt_off(dir * 64 + d0 + e, j0)) = w1; *(LAS u32x2*)(Kt + vt_off(dir * 64 + 32 + d0 + e, j0)) = w2; }
    }
    __syncthreads();
    const int fr = lane & 15, fq = lane >> 4;
    f32x4 acc[8];
#pragma unroll
    for (int ct = 0; ct < 8; ++ct) acc[ct] = (f32x4){0.f, 0.f, 0.f, 0.f};
#pragma unroll
    for (int ks = 0; ks < 4; ++ks) {
        const bf16x8 a = *(const LAS bf16x8*)(Vt + vt_off(16 * wave + fr, 32 * ks + 8 * fq));
#pragma unroll
        for (int ct = 0; ct < 8; ++ct) { const bf16x8 bb = *(const LAS bf16x8*)(Kt + vt_off(16 * ct + fr, 32 * ks + 8 * fq)); acc[ct] = __builtin_amdgcn_mfma_f32_16x16x32_bf16(a, bb, acc[ct], 0, 0, 0); }
    }
    bf16* ob = AT + ((size_t)((b * NH + h) * NPOS + pos)) * 16384;
#pragma unroll
    for (int ct = 0; ct < 8; ++ct)
#pragma unroll
        for (int r = 0; r < 4; ++r) ob[(16 * wave + 4 * fq + r) * 128 + 16 * ct + fr] = f2bf(acc[ct][r]);
    __syncthreads();
}
__device__ __forceinline__ void pool_item(LAS unsigned char* lds, const bf16* Z, bf16* Db, int b, int g, int r, int chh, int tid) {
    LAS float* cs = (LAS float*)lds;
    const int c = tid >> 3, sg = tid & 7, ch0 = g * 128 + chh * 64 + sg * 8, hw = 1 << g;
    const int rlo = (r - hw > 0) ? r - hw : 0, rhi = (r + hw < 32) ? r + hw : 32, clo = (c - hw > 0) ? c - hw : 0, chi = (c + hw < 64) ? c + hw : 64;
    float sum[8], own[8];
#pragma unroll
    for (int e = 0; e < 8; ++e) { sum[e] = 0.f; own[e] = 0.f; }
    for (int rr = rlo; rr < rhi; ++rr) {
        float x[8]; unpack8(*(const u32x4*)(Z + ((size_t)b * SL + rr * 64 + c) * INW + ch0), x);
#pragma unroll
        for (int e = 0; e < 8; ++e) { sum[e] += x[e]; if (rr == r) own[e] = x[e]; }
    }
    *(LAS f32x4*)(cs + c * 68 + sg * 8) = (f32x4){sum[0], sum[1], sum[2], sum[3]}; *(LAS f32x4*)(cs + c * 68 + sg * 8 + 4) = (f32x4){sum[4], sum[5], sum[6], sum[7]};
    __syncthreads();
    f32x4 h0 = (f32x4){0.f, 0.f, 0.f, 0.f}, h1 = h0;
    for (int cc = clo; cc < chi; ++cc) { h0 += *(const LAS f32x4*)(cs + cc * 68 + sg * 8); h1 += *(const LAS f32x4*)(cs + cc * 68 + sg * 8 + 4); }
    const float inv = 1.f / (float)((rhi - rlo) * (chi - clo));
    float o[8];
#pragma unroll
    for (int e = 0; e < 4; ++e) { o[e] = h0[e] * inv - own[e]; o[4 + e] = h1[e] * inv - own[4 + e]; }
    *(u32x4*)(Db + ((size_t)b * SL + r * 64 + c) * PWD + ch0) = pack8(o);
    __syncthreads();
}
__device__ __forceinline__ void scan_item(const bf16* AT, bf16* ST, float lgf2, float lgb2, int bh, int q, int tid) {
    const int e0 = q * 4096 + tid * 8; const bool dirb = ((tid & 15) >= 8);
    const float cd = ex2((dirb ? lgb2 : lgf2) * 128.f);
    const bf16* ab = AT + (size_t)bh * NPOS * 16384 + e0; bf16* sb = ST + (size_t)bh * NCH * 16384 + e0;
    float S[8];
#pragma unroll
    for (int e = 0; e < 8; ++e) S[e] = 0.f;
#pragma unroll
    for (int s = 0; s < NPOS; ++s) {
        if (s >= 2) { const int cc = dirb ? 17 - s : s - 2; *(u32x4*)(sb + (size_t)cc * 16384) = pack8(S); }
        if (s < NPOS - 1) { const int posr = dirb ? (s < 2 ? 1 - s : 19 - s) : s; float a[8]; unpack8(*(const u32x4*)(ab + (size_t)posr * 16384), a);
#pragma unroll
            for (int e = 0; e < 8; ++e) S[e] = cd * S[e] + a[e]; }
    }
}
__device__ __forceinline__ void r3_item(LAS unsigned char* lds, const bf16* Z, const bf16* ST, bf16* YN, const float* __restrict__ gnw, float lgf2, float lgb2,
                                         int b, int h, int c, int tid, int wave, int lane) {
    LAS unsigned char* Qs = lds; LAS unsigned char* Ks = lds + 18432; LAS unsigned char* Vt = lds + 36864; LAS unsigned char* Ps = lds + 71680; LAS unsigned char* Ss = lds + 106496;
    const size_t grow0 = (size_t)b * SL + c * 128;
    {
        const int row = tid >> 2, ds = tid & 3, d0 = ds * 8, tok = c * 128 + row;
        const bf16* zr = Z + (grow0 + row) * INW + h * DK + d0;
        float q1[8], q2[8], k1[8], k2[8];
        unpack8(*(const u32x4*)(zr + Q_OFF), q1); unpack8(*(const u32x4*)(zr + Q_OFF + 32), q2); unpack8(*(const u32x4*)(zr + K_OFF), k1); unpack8(*(const u32x4*)(zr + K_OFF + 32), k2);
        float qa[8], qb[8], ka[8], kb[8];
#pragma unroll
        for (int e = 0; e < 8; ++e) { float cs, sn; rope_cs(tok, d0 + e, cs, sn);
            qa[e] = q1[e] * cs - q2[e] * sn; qb[e] = q1[e] * sn + q2[e] * cs;
            ka[e] = (k1[e] * cs - k2[e] * sn) * 0.125f; kb[e] = (k1[e] * sn + k2[e] * cs) * 0.125f; }
        *(LAS u32x4*)(Qs + row * 144 + d0 * 2) = pack8(qa); *(LAS u32x4*)(Qs + row * 144 + (32 + d0) * 2) = pack8(qb);
        *(LAS u32x4*)(Ks + row * 144 + d0 * 2) = pack8(ka); *(LAS u32x4*)(Ks + row * 144 + (32 + d0) * 2) = pack8(kb);
    }
    stage_vt(Vt, Z + grow0 * INW + V_OFF + h * DV, INW, tid);
    {   const bf16* sp = ST + ((size_t)((b * NH + h) * NCH + c)) * 16384;
#pragma unroll
        for (int i = 0; i < 4; ++i) { const int idx = tid + NTHR * i, v = idx >> 4, seg = idx & 15; *(LAS u32x4*)(Ss + v * 272 + seg * 16) = *(const u32x4*)(sp + v * 128 + seg * 8); } }
    __syncthreads();
    const int fr = lane & 15, fq = lane >> 4, i0 = 16 * wave;
    f32x4 s[8];
#pragma unroll
    for (int ct = 0; ct < 8; ++ct) s[ct] = (f32x4){0.f, 0.f, 0.f, 0.f};
#pragma unroll
    for (int ks = 0; ks < 2; ++ks) {
        const bf16x8 a = *(const LAS bf16x8*)(Qs + (i0 + fr) * 144 + (32 * ks + 8 * fq) * 2);
#pragma unroll
        for (int ct = 0; ct < 8; ++ct) { const bf16x8 bb = *(const LAS bf16x8*)(Ks + (16 * ct + fr) * 144 + (32 * ks + 8 * fq) * 2); s[ct] = __builtin_amdgcn_mfma_f32_16x16x32_bf16(a, bb, s[ct], 0, 0, 0); }
    }
#pragma unroll
    for (int ct = 0; ct < 8; ++ct)
#pragma unroll
        for (int r = 0; r < 4; ++r) { const int i = i0 + 4 * fq + r, j = 16 * ct + fr, df = i - j;
            const float dv = ex2(df >= 0 ? lgf2 * (float)df : lgb2 * (float)(-df));
            *(LAS bf16*)(Ps + i * 272 + j * 2) = f2bf(s[ct][r] * dv); }
    __syncthreads();
    f32x4 o[8];
#pragma unroll
    for (int vt = 0; vt < 8; ++vt) o[vt] = (f32x4){0.f, 0.f, 0.f, 0.f};
#pragma unroll
    for (int ks = 0; ks < 4; ++ks) {
        const bf16x8 a = *(const LAS bf16x8*)(Ps + (i0 + fr) * 272 + (32 * ks + 8 * fq) * 2);
#pragma unroll
        for (int vt = 0; vt < 8; ++vt) { const bf16x8 bb = *(const LAS bf16x8*)(Vt + vt_off(16 * vt + fr, 32 * ks + 8 * fq)); o[vt] = __builtin_amdgcn_mfma_f32_16x16x32_bf16(a, bb, o[vt], 0, 0, 0); }
    }
    {   const int il = i0 + fr; const float dff = ex2(lgf2 * (float)(il + 1)), dbb = ex2(lgb2 * (float)(128 - il));
#pragma unroll
        for (int ks = 0; ks < 4; ++ks) {
            float qv[8]; unpack8(*(const LAS u32x4*)(Qs + il * 144 + (32 * (ks & 1) + 8 * fq) * 2), qv);
            const float dec = (ks < 2) ? dff : dbb;
#pragma unroll
            for (int e = 0; e < 8; ++e) qv[e] *= dec;
            const u32x4 pa = pack8(qv); const bf16x8 a = __builtin_bit_cast(bf16x8, pa);
#pragma unroll
            for (int vt = 0; vt < 8; ++vt) { const bf16x8 bb = *(const LAS bf16x8*)(Ss + (16 * vt + fr) * 272 + (32 * ks + 8 * fq) * 2); o[vt] = __builtin_amdgcn_mfma_f32_16x16x32_bf16(a, bb, o[vt], 0, 0, 0); }
        }
    }
    float gw_[8];
#pragma unroll
    for (int vt = 0; vt < 8; ++vt) gw_[vt] = gnw[h * DV + 16 * vt + fr];
#pragma unroll
    for (int r = 0; r < 4; ++r) {
        float sm = 0.f;
#pragma unroll
        for (int vt = 0; vt < 8; ++vt) sm += o[vt][r];
        sm += __shfl_xor(sm, 1); sm += __shfl_xor(sm, 2); sm += __shfl_xor(sm, 4); sm += __shfl_xor(sm, 8);
        const float mu = sm * (1.f / DV); float vs = 0.f;
#pragma unroll
        for (int vt = 0; vt < 8; ++vt) { const float d = o[vt][r] - mu; vs += d * d; }
        vs += __shfl_xor(vs, 1); vs += __shfl_xor(vs, 2); vs += __shfl_xor(vs, 4); vs += __shfl_xor(vs, 8);
        const float rstd = rsqrtf(vs * (1.f / DV) + EPS);
        const size_t row = grow0 + i0 + 4 * fq + r;
#pragma unroll
        for (int vt = 0; vt < 8; ++vt) { const int col = h * DV + 16 * vt + fr; const float gg = bf1(Z[row * INW + G_OFF + col]);
            YN[row * DM + col] = f2bf((o[vt][r] - mu) * rstd * gw_[vt] * silu_(gg)); }
    }
    __syncthreads();
}

#define XB_TMO      128
#define XB_XCNT(j)  (256  + 64 * (j))
#define XB_XSUB(j)  (1280 + 64 * (j))
#define XB_XGEN(j)  (2304 + 64 * (j))
#define XB_TOP      3328
#define XB_TOPGEN   3392
#define XCD_BAR_WORDS 3456
#define XB_SPIN_CAP (1u << 18)

__device__ __forceinline__ unsigned xb_ld(unsigned* p)              { return __hip_atomic_load(p, __ATOMIC_RELAXED, __HIP_MEMORY_SCOPE_AGENT); }
__device__ __forceinline__ unsigned xb_add(unsigned* p, unsigned v) { return __hip_atomic_fetch_add(p, v, __ATOMIC_RELAXED, __HIP_MEMORY_SCOPE_AGENT); }
__device__ __forceinline__ unsigned xb_xcc_id() { return (unsigned)__builtin_amdgcn_s_getreg((3 << 11) | 20) & 0xFu; }
#define XB_SPIN(cond, bar) do { unsigned _sp = 0; while (cond) { __builtin_amdgcn_s_sleep(1); \
    if ((++_sp & 255u) == 0u) { if (xb_ld(&(bar)[XB_TMO])) break; if (_sp > XB_SPIN_CAP) { atomicAdd(&(bar)[XB_TMO], 1u); break; } } } } while (0)

struct XcdBarrier {
    unsigned* bar; unsigned x;
    volatile LAS unsigned* st;
};

__device__ __forceinline__ XcdBarrier xcd_barrier_post(unsigned* bar, volatile LAS unsigned* st) {
    XcdBarrier b; b.bar = bar; b.x = xb_xcc_id(); b.st = st;
    if (threadIdx.x == 0) (void)xb_add(&bar[XB_XCNT(b.x)], 1u);
    return b;
}
__device__ __forceinline__ void xcd_barrier_complete(unsigned* bar, unsigned x, unsigned& nloc, unsigned& nx) {
    const unsigned G = gridDim.x * gridDim.y * gridDim.z;
    unsigned sum, cnt, mine, sp = 0u;
    for (;;) {
        sum = 0u; cnt = 0u; mine = 0u;
#pragma unroll
        for (unsigned j = 0; j < 16; ++j) { const unsigned c = xb_ld(&bar[XB_XCNT(j)]); sum += c; cnt += (c > 0u) ? 1u : 0u; mine = (j == x) ? c : mine; }
        if (sum == G) break;
        __builtin_amdgcn_s_sleep(1);
        if ((++sp & 255u) == 0u) { if (xb_ld(&bar[XB_TMO])) break; if (sp > XB_SPIN_CAP) { atomicAdd(&bar[XB_TMO], 1u); break; } }
    }
    nloc = mine > 0u ? mine : 1u; nx = cnt > 0u ? cnt : 1u;
}

__device__ __forceinline__ void xcd_barrier(const XcdBarrier& b) {
    asm volatile("s_waitcnt vmcnt(0)" ::: "memory");
    __syncthreads();
    if (threadIdx.x == 0) {
        unsigned* bar = b.bar;
        __builtin_amdgcn_s_waitcnt(0);
        unsigned nloc = b.st[0], nx = b.st[1];
        if (nloc == 0u) { xcd_barrier_complete(bar, b.x, nloc, nx); b.st[0] = nloc; b.st[1] = nx; }
        const unsigned old = xb_add(&bar[XB_XSUB(b.x)], 1u);
        const unsigned gen = old / nloc;
        if (old + 1u == (gen + 1u) * nloc) {
            __builtin_amdgcn_fence(__ATOMIC_RELEASE, "agent");
            asm volatile("s_waitcnt vmcnt(0)" ::: "memory");
            const unsigned og = xb_add(&bar[XB_TOP], 1u);
            const unsigned tg = og / nx;
            if (og + 1u == (tg + 1u) * nx) xb_add(&bar[XB_TOPGEN], 1u);
            else XB_SPIN(xb_ld(&bar[XB_TOPGEN]) == tg, bar);
            __builtin_amdgcn_fence(__ATOMIC_ACQUIRE, "agent");
            xb_add(&bar[XB_XGEN(b.x)], 1u);
            asm volatile("s_waitcnt vmcnt(0)" ::: "memory");
        } else {
            XB_SPIN(xb_ld(&bar[XB_XGEN(b.x)]) == gen, bar);
            __builtin_amdgcn_fence(__ATOMIC_ACQUIRE, "agent");
            asm volatile("s_waitcnt vmcnt(0)" ::: "memory");
        }
    }
    __syncthreads();
}

struct Args { const float* in[21]; float* out; unsigned char* ws; int ph_lo, ph_hi; };
__global__ void __launch_bounds__(NTHR) mk_fwd(Args args) {
    extern __shared__ __attribute__((aligned(16))) unsigned char lds_raw[];
    LAS unsigned char* lds = (LAS unsigned char*)lds_raw;
    cg::grid_group grid = cg::this_grid();
    const int tid = threadIdx.x, lane = tid & 63, wave = __builtin_amdgcn_readfirstlane(tid >> 6);
    const int G = gridDim.x, bx = blockIdx.x, gw = bx * NWAVES + wave, NGW = G * NWAVES;
    const float* x = args.in[0]; const float* cnd = args.in[1]; const float* ctx = args.in[2]; const float* cctx = args.in[3];
    const float* w_ada = args.in[4]; const float* b_ada = args.in[5]; const float* norm_mix = args.in[6]; const float* norm_ffn = args.in[7];
    const float* w_in = args.in[8]; const float* w_pool = args.in[9]; const float* pscale = args.in[10]; const float* dec_f = args.in[11]; const float* dec_b = args.in[12];
    const float* gn_w = args.in[13]; const float* w_pa = args.in[14]; const float* w_rb = args.in[15]; const float* w_o = args.in[16];
    const float* w_ff1 = args.in[17]; const float* w_ff3 = args.in[18]; const float* w_ff2 = args.in[19]; const float* norm_final = args.in[20];
    float* out = args.out; unsigned char* ws = args.ws;
    bf16* W13T = (bf16*)(ws + WS_W13); bf16* W2T = (bf16*)(ws + WS_W2); bf16* WcT = (bf16*)(ws + WS_WCOMB); bf16* WrbT = (bf16*)(ws + WS_WRB); bf16* WoT = (bf16*)(ws + WS_WO);
    float* MODP = (float*)(ws + WS_MODP); float* MOD = (float*)(ws + WS_MOD);
    bf16* Z = (bf16*)(ws + WS_Z); bf16* WinT = (bf16*)(ws + WS_WIN); bf16* H = (bf16*)(ws + WS_H); bf16* HC = (bf16*)(ws + WS_HC); bf16* ZC = (bf16*)(ws + WS_ZC);
    bf16* Db = (bf16*)(ws + WS_D); bf16* ST = (bf16*)(ws + WS_ST); bf16* MG = (bf16*)(ws + WS_MERGED); bf16* H2 = (bf16*)(ws + WS_H2); bf16* HMID = (bf16*)(ws + WS_HMID);
    bf16* AT = (bf16*)out; bf16* YN = (bf16*)out;
    const int lo = args.ph_lo, hi = args.ph_hi;
    const bool one_launch = (hi - lo) > 1;
    volatile LAS unsigned* xst = (volatile LAS unsigned*)(lds + LDS_BYTES - 64);
    unsigned* xbar = (unsigned*)ws;
    if (one_launch) {
        if (tid == 0) { xst[0] = 0u; xst[1] = 0u; }
        if (bx == 0) for (int i = tid; i < XCD_BAR_WORDS; i += NTHR) __hip_atomic_store(xbar + i, 0u, __ATOMIC_RELAXED, __HIP_MEMORY_SCOPE_AGENT);
        __syncthreads();
    }
    XcdBarrier xb; xb.bar = xbar; xb.x = 0; xb.st = xst;
#define IN(k) (lo <= (k) && (k) < hi)
#define SEAM(k) do { if (IN(k) && IN((k) + 1)) { if ((k) == 0) { grid.sync(); xb = xcd_barrier_post(xbar, xst); } else xcd_barrier(xb); } } while (0)

    if (IN(0)) for (int rep_ = 0; rep_ < REPS[0]; ++rep_) {
        LAS float* scr = (LAS float*)(lds + wave * 16384);
        constexpr int I_ADA = 96 * NKC, I_WC = 256, I_IN = (DM / 64) * (INW / 32), I_F1 = (DM / 64) * (DFF / 32), I_F2 = (DFF / 64) * (DM / 32), I_SQ = (DM / 64) * (DM / 32);
        constexpr int NIT = I_ADA + I_WC + I_IN + 2 * I_F1 + I_F2 + 2 * I_SQ;
        for (int it = gw; it < NIT; it += NGW) {
            int r = it;
            if (r < I_ADA) { ada_item(cnd, cctx, w_ada, MODP, r, lane); continue; } r -= I_ADA;
            if (r < I_WC) { wcomb_item(w_pool, pscale, w_pa, WcT, r, lane); continue; } r -= I_WC;
            if (r < I_IN) { transpose_item(w_in, DM, INW, WinT, 0, scr, r, lane); continue; } r -= I_IN;
            if (r < I_F1) { transpose_item(w_ff1, DM, DFF, W13T, 1, scr, r, lane); continue; } r -= I_F1;
            if (r < I_F1) { transpose_item(w_ff3, DM, DFF, W13T, 2, scr, r, lane); continue; } r -= I_F1;
            if (r < I_F2) { transpose_item(w_ff2, DFF, DM, W2T, 0, scr, r, lane); continue; } r -= I_F2;
            if (r < I_SQ) { transpose_item(w_rb, DM, DM, WrbT, 0, scr, r, lane); continue; } r -= I_SQ;
            transpose_item(w_o, DM, DM, WoT, 0, scr, r, lane);
        }
    }
    SEAM(0);
    if (IN(1)) for (int rep_ = 0; rep_ < REPS[1]; ++rep_) {
        p1_norm(x, ctx, norm_mix, b_ada, MODP, H, HC, gw, NGW, lane);
        for (int i = bx * NTHR + tid; i < 9 * MODW; i += G * NTHR) { float s = b_ada[i % MODW];
#pragma unroll
            for (int kc = 0; kc < NKC; ++kc) s += MODP[(size_t)kc * 9 * MODW + i];
            MOD[i] = s; }
    }
    SEAM(1);
    if (IN(2)) for (int rep_ = 0; rep_ < REPS[2]; ++rep_) {
        pg8::Gemm g{H, WinT, HC, WinT + (size_t)K_OFF * DM, DM}; pg8::StaticOrder S; S.init(MT, INW, G, bx, MCX, 1536);
        EpiZ E{Z, ZC};
        pg8::gemm_phase<EpiZ, pg8::StaticOrder, true, true>(lds, g, S, E);
    }
    SEAM(2);
    if (IN(3)) for (int rep_ = 0; rep_ < REPS[3]; ++rep_) {
        constexpr int N_A = NB * NH * NPOS, N_P = NB * 4 * 32 * 2;
        for (int it = bx; it < N_A + N_P; it += G) {
            if (it < N_A) { const int bh = it / NPOS, pos = it % NPOS, b = bh >> 3, h = bh & 7;
                a_item(lds, Z, ZC, AT, log2_sigmoid(dec_f[h]), log2_sigmoid(dec_b[h]), b, h, pos, tid, wave, lane); }
            else { const int r_ = it - N_A, g = 3 - (r_ >> 9), rem = r_ & 511, b = rem >> 6, rr = (rem >> 1) & 31, chh = rem & 1;
                pool_item(lds, Z, Db, b, g, rr, chh, tid); }
        }
    }
    SEAM(3);
    if (IN(4)) for (int rep_ = 0; rep_ < REPS[4]; ++rep_) {
        for (int it = bx; it < NB * NH * 4; it += G) { const int bh = it >> 2, q = it & 3, h = bh & 7;
            scan_item(AT, ST, log2_sigmoid(dec_f[h]), log2_sigmoid(dec_b[h]), bh, q, tid); }
    }
    SEAM(4);
    if (IN(5)) for (int rep_ = 0; rep_ < REPS[5]; ++rep_) {
        for (int it = bx; it < NB * NH * NCH; it += G) { const int bh = it >> 4, c = it & 15, b = bh >> 3, h = bh & 7;
            r3_item(lds, Z, ST, YN, gn_w, log2_sigmoid(dec_f[h]), log2_sigmoid(dec_b[h]), b, h, c, tid, wave, lane); }
    }
    SEAM(5);
    if (IN(6)) for (int rep_ = 0; rep_ < REPS[6]; ++rep_) {
        { pg8::Gemm g{Db, WcT, Db, WcT, PWD}; pg8::StaticOrder S; S.init(MT, DM, G, bx); EpiGate<false> E{Z, GA_OFF, MG};
          pg8::gemm_phase<EpiGate<false>, pg8::StaticOrder, true, true>(lds, g, S, E); }
        { pg8::Gemm g{YN, WrbT, YN, WrbT, DM}; pg8::StaticOrder S; S.init(MT, DM, G, bx); EpiGate<true> E{Z, GB_OFF, MG};
          pg8::gemm_phase<EpiGate<true>, pg8::StaticOrder, true, true>(lds, g, S, E); }
    }
    SEAM(6);
    if (IN(7)) for (int rep_ = 0; rep_ < REPS[7]; ++rep_) {
        pg8::Gemm g{MG, WoT, MG, WoT, DM}; pg8::StaticOrder S; S.init(MT, DM, G, bx); EpiRes E{x, out, MOD, 2 * DM};
        pg8::gemm_phase<EpiRes, pg8::StaticOrder, true, true>(lds, g, S, E);
    }
    SEAM(7);
    if (IN(8)) for (int rep_ = 0; rep_ < REPS[8]; ++rep_) p8_norm(out, norm_ffn, MOD, H2, gw, NGW, lane);
    SEAM(8);
    if (IN(9)) for (int rep_ = 0; rep_ < REPS[9]; ++rep_) {
        pg8::Gemm g{H2, W13T, H2, W13T, DM}; pg8::StaticOrder S; S.init(MT, 2 * DFF, G, bx); EpiSwiglu E{HMID};
        pg8::gemm_phase<EpiSwiglu, pg8::StaticOrder, true, true>(lds, g, S, E);
    }
    SEAM(9);
    if (IN(10)) for (int rep_ = 0; rep_ < REPS[10]; ++rep_) {
        pg8::Gemm g{HMID, W2T, HMID, W2T, DFF}; pg8::StaticOrder S; S.init(MT, DM, G, bx); EpiRes E{out, out, MOD, 5 * DM};
        pg8::gemm_phase<EpiRes, pg8::StaticOrder, true, true>(lds, g, S, E);
    }
    SEAM(10);
    if (IN(11)) p11_norm(out, norm_final, gw, NGW, lane);
#undef IN
#undef SEAM
}

extern "C" void kernel_launch(void* const* d_in, const int* in_sizes, int n_in, void* d_out, int out_size, void* d_ws, size_t ws_size, hipStream_t stream) {
    static int grid = 0;
    if (grid == 0) {
        if (n_in != 21 || out_size != MT * DM || ws_size < WS_END) { fprintf(stderr, "kernel_launch: unexpected problem (n_in %d, out %d, ws %zu)\n", n_in, out_size, ws_size); grid = -1; return; }
        int dev = 0, cus = 0, per_cu = 0;
        (void)hipGetDevice(&dev); (void)hipDeviceGetAttribute(&cus, hipDeviceAttributeMultiprocessorCount, dev);
        if (hipFuncSetAttribute((const void*)mk_fwd, hipFuncAttributeMaxDynamicSharedMemorySize, LDS_BYTES) != hipSuccess) { fprintf(stderr, "kernel_launch: hipFuncSetAttribute failed\n"); grid = -1; return; }
        if (hipOccupancyMaxActiveBlocksPerMultiprocessor(&per_cu, (const void*)mk_fwd, NTHR, LDS_BYTES) != hipSuccess || per_cu < 1) per_cu = 1;
        (void)hipGetLastError();
        if (cus <= 0) cus = 256;
        grid = cus * per_cu;
    }
    if (grid < 0) return;
    Args a{};
    for (int i = 0; i < 21; ++i) a.in[i] = (const float*)d_in[i];
    a.out = (float*)d_out; a.ws = (unsigned char*)d_ws;
#if MK_PER_PHASE
    for (int p = 0; p < NPHASE; ++p) { a.ph_lo = p; a.ph_hi = p + 1; hipLaunchKernelGGL(mk_fwd, dim3(grid), dim3(NTHR), LDS_BYTES, stream, a); }
#else
    a.ph_lo = 0; a.ph_hi = NPHASE;
    void* kargs[] = {(void*)&a};
    hipError_t e = hipLaunchCooperativeKernel((const void*)mk_fwd, dim3(grid), dim3(NTHR), kargs, LDS_BYTES, stream);
    if (e != hipSuccess) fprintf(stderr, "kernel_launch: cooperative launch failed: %s (grid %d)\n", hipGetErrorString(e), grid);
#endif
}
```

```cpp
#include <hip/hip_runtime.h>
#include <hip/hip_cooperative_groups.h>
#include <cstdio>
#include <cstdint>
namespace cg = cooperative_groups;

#ifndef MK_PER_PHASE
#define MK_PER_PHASE 0
#endif

namespace pg8 {
#define PG8_LAS __attribute__((address_space(3)))
typedef unsigned short bf16_t;
typedef short bf16x8 __attribute__((ext_vector_type(8)));
typedef float f32x4 __attribute__((ext_vector_type(4)));
typedef unsigned u32x4 __attribute__((ext_vector_type(4)));
constexpr int BM = 256, BK = 64, HALF = 128, HTB = HALF * BK * 2  , STAGE_BYTES = 8 * HTB, NXCD = 8, WGM = 8;

__host__ __device__ __forceinline__ int lds_byte(int r, int c) { const int st = (r >> 4) * 2 + (c >> 5), rr = r & 15, cc = c & 31, ob = rr * 64 + cc * 2; return st * 1024 + (ob ^ (((ob >> 9) & 1) << 5)); }
__host__ __device__ __forceinline__ void stage_rc(int b, int& R, int& C) { const int st = b / 1024, sb = b % 1024, swz = sb ^ (((sb >> 9) & 1) << 5); R = (st >> 1) * 16 + swz / 64; C = (st & 1) * 32 + (swz % 64) / 2; }
__host__ __device__ __forceinline__ int perm32(int rho) { const int n = rho >> 4, i = rho & 15; return 8 * (i >> 2) + 4 * n + (i & 3); }

struct Unit { int pm, pn, g; };
struct Gemm { const bf16_t* A; const bf16_t* Bt; const bf16_t* A2; const bf16_t* Bt2; int K;
    __device__ __forceinline__ const char* abase(const Unit& u) const { return (const char*)(u.g ? A2 : A) + (size_t)u.pm * (size_t)(2 * HALF) * K * 2; }
    __device__ __forceinline__ const char* bbase(const Unit& u) const { return (const char*)(u.g ? Bt2 : Bt) + (size_t)u.pn * (size_t)(2 * HALF) * K * 2; } };

struct StaticOrder {
    int nM, nN, nwg, G, c;
    int n2M, n2N;
    __host__ __device__ void init(int M, int N, int G_, int c_, int M2 = 0, int N2 = 0) { nM = M / BM; nN = N / BM; nwg = nM * nN; G = G_; c = c_; n2M = M2 / BM; n2N = N2 / BM; }
    __host__ __device__ bool next(int i, Unit& u) const {
        const long L = (long)i * G + c; u.g = 0;
        if (L >= nwg) { const long j = L - nwg; if (j >= (long)n2M * n2N) return false; u.g = 1; u.pm = (int)(j % n2M); u.pn = (int)(j / n2M); return true; }
        int wgid = (int)L; { const int q = nwg / NXCD, r = nwg % NXCD, xcd = wgid % NXCD, off = wgid / NXCD; wgid = (xcd < r ? xcd * (q + 1) : r * (q + 1) + (xcd - r) * q) + off; }
        const int nig = WGM * nN, gid = wgid / nig, fm = gid * WGM, gsz = (nM - fm) < WGM ? (nM - fm) : WGM;
        u.pm = fm + ((wgid % nig) % gsz); u.pn = (wgid % nig) / gsz; return true;
    }
    __device__ __forceinline__ void a_ready(const Unit&) const {}
    __device__ __forceinline__ void done(const Unit&) const {}
};

__device__ __forceinline__ unsigned cvt_pk_bf16(float lo, float hi) { unsigned r; asm volatile("v_cvt_pk_bf16_f32 %0, %1, %2" : "=v"(r) : "v"(lo), "v"(hi)); return r; }


template <class Epi, class Sched, bool ALIGN_EPI = false, bool SP2 = false>
__device__ __forceinline__ void gemm_phase(PG8_LAS unsigned char* lds, const Gemm g, const Sched& S, const Epi& E) {
    const int tid = threadIdx.x, wid = __builtin_amdgcn_readfirstlane(tid >> 6), lane = tid & 63, wr = wid >> 2, wc = wid & 3, fr = lane & 15, fq = lane >> 4;
    const int K = g.K, nt = K / BK;
    unsigned voffA[2], voffB[2];
#pragma unroll
    for (int i = 0; i < 2; ++i) { int R, C; stage_rc(tid * 16 + i * 8192, R, C); const int Rb = Epi::PERM ? ((R & ~31) + perm32(R & 31)) : R;
        voffA[i] = (unsigned)(R * K + C) * 2u; voffB[i] = (unsigned)(Rb * K + C) * 2u; }
    const size_t kstep = (size_t)(BK * 2);
    const size_t hstep = (size_t)HALF * K * 2;
    const unsigned ldsw = (unsigned)wid * 1024u;
    const int aoff = lds_byte(wr * 64 + fr, fq * 8), boff = lds_byte(wc * 32 + fr, fq * 8);
#define PG8_SA(b, h) (((b) * 2 + (h)) * HTB)
#define PG8_SB(b, h) ((4 + (b) * 2 + (h)) * HTB)
#define PG8_STAGE(bufoff, gbase, voff) do { _Pragma("unroll") for (int _i = 0; _i < 2; ++_i) \
        __builtin_amdgcn_global_load_lds((const unsigned*)((const char*)(gbase) + (voff)[_i]), (PG8_LAS unsigned*)(lds + (bufoff) + ldsw + _i * 8192), 16, 0, 0); } while (0)
#define PG8_LDA(dst, b, h) do { _Pragma("unroll") for (int m = 0; m < 4; ++m) _Pragma("unroll") for (int k = 0; k < 2; ++k) dst[m][k] = *(const PG8_LAS bf16x8*)(lds + PG8_SA(b, h) + aoff + m * 2048 + k * 1024); } while (0)
#define PG8_LDB(dst, b, h) do { _Pragma("unroll") for (int n = 0; n < 2; ++n) _Pragma("unroll") for (int k = 0; k < 2; ++k) dst[n][k] = *(const PG8_LAS bf16x8*)(lds + PG8_SB(b, h) + boff + n * 2048 + k * 1024); } while (0)
#define PG8_MMA(ai, bj, At, Bt) do { __builtin_amdgcn_s_setprio(1); _Pragma("unroll") for (int m = 0; m < 4; ++m) _Pragma("unroll") for (int n = 0; n < 2; ++n) _Pragma("unroll") for (int k = 0; k < 2; ++k) \
        acc[ai][bj][m][n] = __builtin_amdgcn_mfma_f32_16x16x32_bf16(Bt[n][k], At[m][k], acc[ai][bj][m][n], 0, 0, 0); __builtin_amdgcn_s_setprio(0); } while (0)
#define PG8_WAIT_V(n) asm volatile("s_waitcnt vmcnt(" #n ")" ::: "memory")
#define PG8_WAIT_L(n) asm volatile("s_waitcnt lgkmcnt(" #n ")" ::: "memory")
#define PG8_BAR __builtin_amdgcn_s_barrier()
#define PG8_SCHED __builtin_amdgcn_sched_barrier(0)
    Unit cur, nxt; int ui = 0;
    if (!S.next(0, cur)) return;
    f32x4 acc[2][2][4][2];
#pragma unroll
    for (int a = 0; a < 2; ++a)
#pragma unroll
        for (int b = 0; b < 2; ++b)
#pragma unroll
            for (int m = 0; m < 4; ++m)
#pragma unroll
                for (int n = 0; n < 2; ++n) acc[a][b][m][n] = (f32x4){0.f, 0.f, 0.f, 0.f};
    bf16x8 At[4][2], B0[2][2], B1[2][2];
    const char* cA = g.abase(cur); const char* cB = g.bbase(cur);
    S.a_ready(cur);
    if constexpr (SP2) {
        PG8_STAGE(PG8_SB(0, 0), cB, voffB); PG8_STAGE(PG8_SB(0, 1), cB + hstep, voffB); PG8_STAGE(PG8_SA(0, 0), cA, voffA); PG8_STAGE(PG8_SA(0, 1), cA + hstep, voffA);
        if (wr == 1) PG8_BAR;
        PG8_WAIT_V(2); PG8_BAR;
        PG8_STAGE(PG8_SB(1, 0), cB + kstep, voffB); PG8_STAGE(PG8_SA(1, 0), cA + kstep, voffA); PG8_STAGE(PG8_SB(1, 1), cB + hstep + kstep, voffB);
        PG8_WAIT_V(6); PG8_BAR;
    } else {
        PG8_STAGE(PG8_SB(0, 0), cB, voffB); PG8_STAGE(PG8_SA(0, 0), cA, voffA); PG8_STAGE(PG8_SB(0, 1), cB + hstep, voffB); PG8_STAGE(PG8_SA(0, 1), cA + hstep, voffA);
        if (wr == 1) PG8_BAR;
        PG8_WAIT_V(4); PG8_BAR;
        PG8_STAGE(PG8_SB(1, 0), cB + kstep, voffB); PG8_STAGE(PG8_SA(1, 0), cA + kstep, voffA); PG8_STAGE(PG8_SB(1, 1), cB + hstep + kstep, voffB);
        PG8_WAIT_V(6); PG8_BAR;
    }
    for (;;) {
        const bool has_next = S.next(ui + 1, nxt);
        const char* nA = has_next ? g.abase(nxt) : cA; const char* nB = has_next ? g.bbase(nxt) : cB;
        for (int t = 0; t < nt; t += 2) {
            const bool last = (t == nt - 2);
            const char* a1 = cA + (size_t)(t + 1) * kstep;
            const char* a2 = last ? nA : cA + (size_t)(t + 2) * kstep; const char* b2 = last ? nB : cB + (size_t)(t + 2) * kstep;
            const char* a3 = a2 + kstep; const char* b3 = b2 + kstep;
            if (last && has_next) S.a_ready(nxt);
            if constexpr (SP2) {
            PG8_LDB(B0, 0, 0); PG8_LDB(B1, 0, 1); PG8_SCHED; PG8_LDA(At, 0, 0); PG8_STAGE(PG8_SA(1, 1), a1 + hstep, voffA);
            PG8_WAIT_V(8); PG8_WAIT_L(0); PG8_BAR; PG8_MMA(0, 0, At, B0); PG8_MMA(0, 1, At, B1); PG8_BAR; PG8_SCHED;
            PG8_LDA(At, 0, 1); PG8_STAGE(PG8_SB(0, 0), b2, voffB); PG8_STAGE(PG8_SB(0, 1), b2 + hstep, voffB); PG8_STAGE(PG8_SA(0, 0), a2, voffA);
            PG8_WAIT_V(8); PG8_WAIT_L(0); PG8_BAR; PG8_MMA(1, 0, At, B0); PG8_MMA(1, 1, At, B1); PG8_BAR; PG8_SCHED;
            PG8_LDB(B0, 1, 0); PG8_LDB(B1, 1, 1); PG8_SCHED; PG8_LDA(At, 1, 0); PG8_STAGE(PG8_SA(0, 1), a2 + hstep, voffA);
            PG8_WAIT_V(8); PG8_WAIT_L(0); PG8_BAR; PG8_MMA(0, 0, At, B0); PG8_MMA(0, 1, At, B1); PG8_BAR; PG8_SCHED;
            PG8_LDA(At, 1, 1); PG8_STAGE(PG8_SB(1, 0), b3, voffB); PG8_STAGE(PG8_SB(1, 1), b3 + hstep, voffB); PG8_STAGE(PG8_SA(1, 0), a3, voffA);
            PG8_WAIT_V(8); PG8_WAIT_L(0); PG8_BAR; PG8_MMA(1, 0, At, B0); PG8_MMA(1, 1, At, B1); PG8_BAR; PG8_SCHED;
            } else {
            PG8_LDB(B0, 0, 0); PG8_SCHED; PG8_LDA(At, 0, 0); PG8_STAGE(PG8_SA(1, 1), a1 + hstep, voffA);
            PG8_WAIT_L(8); PG8_BAR; PG8_WAIT_L(0); PG8_MMA(0, 0, At, B0); PG8_BAR; PG8_SCHED;
            PG8_LDB(B1, 0, 1); PG8_STAGE(PG8_SB(0, 0), b2, voffB);
            PG8_BAR; PG8_WAIT_L(0); PG8_MMA(0, 1, At, B1); PG8_BAR;
            PG8_LDA(At, 0, 1); PG8_STAGE(PG8_SA(0, 0), a2, voffA);
            PG8_BAR; PG8_WAIT_L(0); PG8_MMA(1, 0, At, B0); PG8_BAR; PG8_SCHED;
            PG8_STAGE(PG8_SB(0, 1), b2 + hstep, voffB);
            PG8_WAIT_V(6); PG8_BAR; PG8_MMA(1, 1, At, B1); PG8_BAR;
            PG8_LDB(B0, 1, 0); PG8_SCHED; PG8_LDA(At, 1, 0); PG8_STAGE(PG8_SA(0, 1), a2 + hstep, voffA);
            PG8_WAIT_L(8); PG8_BAR; PG8_WAIT_L(0); PG8_MMA(0, 0, At, B0); PG8_BAR; PG8_SCHED;
            PG8_LDB(B1, 1, 1); PG8_STAGE(PG8_SB(1, 0), b3, voffB);
            PG8_BAR; PG8_WAIT_L(0); PG8_MMA(0, 1, At, B1); PG8_BAR;
            PG8_LDA(At, 1, 1); PG8_STAGE(PG8_SA(1, 0), a3, voffA);
            PG8_BAR; PG8_WAIT_L(0); PG8_MMA(1, 0, At, B0); PG8_BAR; PG8_SCHED;
            PG8_STAGE(PG8_SB(1, 1), b3 + hstep, voffB);
            PG8_WAIT_V(6); PG8_BAR; PG8_MMA(1, 1, At, B1); PG8_BAR;
            }
        }
        if constexpr (ALIGN_EPI) { if (wr == 0) PG8_BAR; }
        if constexpr (!Epi::AFTER_DRAIN) { E(acc, cur, wr, wc, fr, fq); S.done(cur); }
        if (!has_next) break;
#pragma unroll
        for (int a = 0; a < 2; ++a)
#pragma unroll
            for (int b = 0; b < 2; ++b)
#pragma unroll
                for (int m = 0; m < 4; ++m)
#pragma unroll
                    for (int n = 0; n < 2; ++n) acc[a][b][m][n] = (f32x4){0.f, 0.f, 0.f, 0.f};
        cur = nxt; cA = nA; cB = nB; ++ui;
        if constexpr (ALIGN_EPI) { if (wr == 1) PG8_BAR; }
    }
    PG8_WAIT_V(0);
    if constexpr (!ALIGN_EPI) { if (wr == 0) PG8_BAR; }
    PG8_BAR;
    if constexpr (Epi::AFTER_DRAIN) { E.fused(acc, cur, wr, wc, fr, fq, lds, wid, lane); S.done(cur); }
#undef PG8_SA
#undef PG8_SB
#undef PG8_STAGE
#undef PG8_LDA
#undef PG8_LDB
#undef PG8_MMA
#undef PG8_WAIT_V
#undef PG8_WAIT_L
#undef PG8_BAR
#undef PG8_SCHED
}
}

using pg8::f32x4; using pg8::bf16x8; using pg8::u32x4; using pg8::Unit;
#define LAS __attribute__((address_space(3)))
typedef unsigned short bf16;
typedef unsigned u32x2 __attribute__((ext_vector_type(2)));
typedef float f32x2_t __attribute__((ext_vector_type(2)));
typedef __bf16 bf16x2_t __attribute__((ext_vector_type(2)));
#define LDS_WAIT() asm volatile("s_waitcnt lgkmcnt(0)" ::: "memory")

constexpr int NWAVES = 8, NTHR = 512;
constexpr int DM = 1024, NB = 8, SL = 2048, MT = NB * SL, LCX = 256, MCX = NB * LCX;
constexpr int INW = 5632, DFF = 2816, PWD = 512, NH = 8, DK = 64, DV = 128;
constexpr int Q_OFF = 512, K_OFF = 1024, V_OFF = 1536, G_OFF = 2560, GA_OFF = 3584, GB_OFF = 4608;
constexpr int NPOS = 18, NCH = 16, MODW = 6 * DM, NKC = 16;
constexpr float EPS = 1e-6f, LOG2E = 1.4426950408889634f;
constexpr int LDS_BYTES = 147456;
constexpr int NPHASE = 12;
#ifndef MK_REPS
#define MK_REPS {1,1,1,1,1,1,1,1,1,1,1,1}
#endif
__device__ constexpr int REPS[NPHASE] = MK_REPS;

constexpr size_t MiB = 1u << 20;
constexpr size_t WS_W13 = 1 * MiB, WS_W2 = 12 * MiB, WS_WCOMB = 17 * MiB + MiB / 2, WS_WRB = 18 * MiB + MiB / 2, WS_WO = 20 * MiB + MiB / 2;
constexpr size_t WS_MOD = 23 * MiB + MiB / 2, WS_Z = 24 * MiB, WS_MODP = WS_Z  , WS_SA = 200 * MiB, WS_END = 256 * MiB;
constexpr size_t WS_WIN = WS_SA, WS_H = WS_SA + 11 * MiB, WS_HC = WS_SA + 43 * MiB, WS_ZC = WS_SA + 47 * MiB;
constexpr size_t WS_D = WS_SA, WS_ST = WS_SA + 16 * MiB, WS_MERGED = WS_SA + 16 * MiB, WS_H2 = WS_SA, WS_HMID = WS_Z;
static_assert(WS_ZC + (size_t)MCX * 1536 * 2 <= WS_END && WS_ST + (size_t)64 * 16 * 16384 * 2 <= WS_END && WS_Z + (size_t)MT * INW * 2 <= WS_SA, "ws map");
static_assert((size_t)64 * NPOS * 16384 * 2 <= (size_t)MT * DM * 4, "ws map 2");

__device__ __forceinline__ unsigned pk2(float lo, float hi) { f32x2_t v = {lo, hi}; bf16x2_t b = __builtin_convertvector(v, bf16x2_t); return __builtin_bit_cast(unsigned, b); }
__device__ __forceinline__ bf16 f2bf(float f) { return (bf16)(pk2(f, 0.f) & 0xffffu); }
__device__ __forceinline__ float bflo(unsigned u) { return __uint_as_float(u << 16); }
__device__ __forceinline__ float bfhi(unsigned u) { return __uint_as_float(u & 0xffff0000u); }
__device__ __forceinline__ float bf1(bf16 v) { return __uint_as_float((unsigned)v << 16); }
__device__ __forceinline__ float wave_sum(float v) {
#pragma unroll
    for (int o = 1; o < 64; o <<= 1) v += __shfl_xor(v, o);
    return v;
}
__device__ __forceinline__ float sigmoid_(float x) { return __builtin_amdgcn_rcpf(1.f + __builtin_amdgcn_exp2f(-x * LOG2E)); }
__device__ __forceinline__ float silu_(float x) { return x * sigmoid_(x); }
__device__ __forceinline__ float ex2(float x) { return __builtin_amdgcn_exp2f(x); }
__device__ __forceinline__ float log2_sigmoid(float x) { return -log1pf(expf(-x)) * LOG2E; }
__device__ __forceinline__ void unpack8(const u32x4 r, float (&f)[8]) {
    f[0] = bflo(r.x); f[1] = bfhi(r.x); f[2] = bflo(r.y); f[3] = bfhi(r.y); f[4] = bflo(r.z); f[5] = bfhi(r.z); f[6] = bflo(r.w); f[7] = bfhi(r.w);
}
__device__ __forceinline__ u32x4 pack8(const float (&f)[8]) { u32x4 o; o.x = pk2(f[0], f[1]); o.y = pk2(f[2], f[3]); o.z = pk2(f[4], f[5]); o.w = pk2(f[6], f[7]); return o; }

struct EpiZ {
    static constexpr bool PERM = true, AFTER_DRAIN = false;
    bf16* Z; bf16* ZC;
    __device__ __forceinline__ void operator()(const f32x4 (&acc)[2][2][4][2], const Unit& u, int wr, int wc, int fr, int fq) const {
        bf16* base = u.g ? ZC : Z; const int ldc = u.g ? 1536 : INW; const bool sig = (u.g == 0) && (u.pn >= GA_OFF / 256);
        const int row0 = u.pm * 256 + wr * 64 + fr, col0 = u.pn * 256 + wc * 32 + 8 * fq;
#pragma unroll
        for (int ai = 0; ai < 2; ++ai)
#pragma unroll
            for (int m = 0; m < 4; ++m) { bf16* rowp = base + (size_t)(row0 + ai * 128 + m * 16) * ldc + col0;
#pragma unroll
                for (int bj = 0; bj < 2; ++bj) { f32x4 v0 = acc[ai][bj][m][0], v1 = acc[ai][bj][m][1];
                    if (sig) {
#pragma unroll
                        for (int e = 0; e < 4; ++e) { v0[e] = sigmoid_(v0[e]); v1[e] = sigmoid_(v1[e]); } }
                    u32x4 w; w.x = pk2(v0[0], v0[1]); w.y = pk2(v0[2], v0[3]); w.z = pk2(v1[0], v1[1]); w.w = pk2(v1[2], v1[3]);
                    *(u32x4*)(rowp + bj * 128) = w; } }
    }
};
template <bool ADD> struct EpiGate {
    static constexpr bool PERM = true, AFTER_DRAIN = false;
    const bf16* Z; int goff; bf16* O;
    __device__ __forceinline__ void operator()(const f32x4 (&acc)[2][2][4][2], const Unit& u, int wr, int wc, int fr, int fq) const {
        const int row0 = u.pm * 256 + wr * 64 + fr, col0 = u.pn * 256 + wc * 32 + 8 * fq;
#pragma unroll
        for (int ai = 0; ai < 2; ++ai) {
            u32x4 gt[4][2], ov[4][2];
#pragma unroll
            for (int m = 0; m < 4; ++m)
#pragma unroll
                for (int bj = 0; bj < 2; ++bj) { const size_t row = (size_t)(row0 + ai * 128 + m * 16); const int col = col0 + bj * 128;
                    gt[m][bj] = *(const u32x4*)(Z + row * INW + goff + col); if (ADD) ov[m][bj] = *(const u32x4*)(O + row * DM + col); }
#pragma unroll
            for (int m = 0; m < 4; ++m)
#pragma unroll
                for (int bj = 0; bj < 2; ++bj) { const size_t row = (size_t)(row0 + ai * 128 + m * 16); const int col = col0 + bj * 128;
                    float g[8], o[8]; unpack8(gt[m][bj], g); if (ADD) unpack8(ov[m][bj], o);
#pragma unroll
                    for (int e = 0; e < 8; ++e) { const float a = acc[ai][bj][m][e >> 2][e & 3]; o[e] = ADD ? (o[e] + g[e] * a) : (g[e] * a); }
                    *(u32x4*)(O + row * DM + col) = pack8(o); }
        }
    }
};
struct EpiRes {
    static constexpr bool PERM = true, AFTER_DRAIN = false;
    const float* base; float* out; const float* mod; int goff;
    __device__ __forceinline__ void operator()(const f32x4 (&acc)[2][2][4][2], const Unit& u, int wr, int wc, int fr, int fq) const {
        const int row0 = u.pm * 256 + wr * 64 + fr, col0 = u.pn * 256 + wc * 32 + 8 * fq, b = u.pm >> 3;
        const float* gp = mod + (size_t)b * MODW + goff + col0;
        f32x4 gv[2][2];
#pragma unroll
        for (int bj = 0; bj < 2; ++bj)
#pragma unroll
            for (int n = 0; n < 2; ++n) gv[bj][n] = *(const f32x4*)(gp + bj * 128 + 4 * n);
#pragma unroll
        for (int ai = 0; ai < 2; ++ai) {
            f32x4 bv[4][2][2];
#pragma unroll
            for (int m = 0; m < 4; ++m)
#pragma unroll
                for (int bj = 0; bj < 2; ++bj)
#pragma unroll
                    for (int n = 0; n < 2; ++n) bv[m][bj][n] = *(const f32x4*)(base + (size_t)(row0 + ai * 128 + m * 16) * DM + col0 + bj * 128 + 4 * n);
#pragma unroll
            for (int m = 0; m < 4; ++m)
#pragma unroll
                for (int bj = 0; bj < 2; ++bj)
#pragma unroll
                    for (int n = 0; n < 2; ++n) *(f32x4*)(out + (size_t)(row0 + ai * 128 + m * 16) * DM + col0 + bj * 128 + 4 * n) = bv[m][bj][n] + gv[bj][n] * acc[ai][bj][m][n];
        }
    }
};
struct EpiSwiglu {
    static constexpr bool PERM = true, AFTER_DRAIN = false;
    bf16* O;
    __device__ __forceinline__ void operator()(const f32x4 (&acc)[2][2][4][2], const Unit& u, int wr, int wc, int fr, int fq) const {
        const int row0 = u.pm * 256 + wr * 64 + fr, col0 = u.pn * 128 + wc * 32 + 8 * fq;
#pragma unroll
        for (int ai = 0; ai < 2; ++ai)
#pragma unroll
            for (int m = 0; m < 4; ++m) { float o[8];
#pragma unroll
                for (int e = 0; e < 8; ++e) o[e] = silu_(acc[ai][0][m][e >> 2][e & 3]) * acc[ai][1][m][e >> 2][e & 3];
                *(u32x4*)(O + (size_t)(row0 + ai * 128 + m * 16) * DFF + col0) = pack8(o); }
    }
};

__device__ __forceinline__ void transpose_item(const float* __restrict__ W, int K, int N, bf16* WT, int mode, LAS float* scr, int item, int lane) {
    const int nblk = N / 32, kb = item / nblk, nb = item % nblk, k0 = 64 * kb, n0 = 32 * nb;
    float tv[32];
#pragma unroll
    for (int i = 0; i < 32; ++i) tv[i] = W[(size_t)(k0 + 2 * i + (lane >> 5)) * N + n0 + (lane & 31)];
#pragma unroll
    for (int i = 0; i < 32; ++i) scr[(2 * i + (lane >> 5)) * 33 + (lane & 31)] = tv[i];
    LDS_WAIT(); asm volatile("" ::: "memory");
    const int c = lane & 7;
    const int drow0 = (mode == 0) ? n0 : (256 * (n0 >> 7) + (n0 & 127) + (mode == 2 ? 128 : 0));
#pragma unroll
    for (int j = 0; j < 4; ++j) { const int n = (lane >> 3) + 8 * j; const LAS float* s = scr + (8 * c) * 33 + n;
        u32x4 o; o.x = pk2(s[0 * 33], s[1 * 33]); o.y = pk2(s[2 * 33], s[3 * 33]); o.z = pk2(s[4 * 33], s[5 * 33]); o.w = pk2(s[6 * 33], s[7 * 33]);
        *(u32x4*)(WT + (size_t)(drow0 + n) * K + k0 + 8 * c) = o; }
    LDS_WAIT(); asm volatile("" ::: "memory");
}
__device__ __forceinline__ void wcomb_item(const float* __restrict__ w_pool, const float* __restrict__ pscale, const float* __restrict__ w_pa, bf16* WcT, int item, int lane) {
    const int g = item >> 7, rem = item & 127, n = (rem >> 3) * 64 + lane, c0 = (rem & 7) * 16;
    float wcol[128];
#pragma unroll
    for (int d = 0; d < 128; ++d) wcol[d] = w_pa[(size_t)(g * 128 + d) * DM + n];
#pragma unroll
    for (int d = 0; d < 128; ++d) wcol[d] *= pscale[g * 128 + d];
    float res[16];
#pragma unroll 2
    for (int cc = 0; cc < 16; ++cc) { const float* wr = w_pool + (size_t)(g * 128 + c0 + cc) * 128; float a0 = 0.f, a1 = 0.f;
#pragma unroll
        for (int d = 0; d < 128; d += 2) { a0 += wr[d] * wcol[d]; a1 += wr[d + 1] * wcol[d + 1]; }
        res[cc] = a0 + a1; }
    u32x4 o0, o1; o0.x = pk2(res[0], res[1]); o0.y = pk2(res[2], res[3]); o0.z = pk2(res[4], res[5]); o0.w = pk2(res[6], res[7]);
    o1.x = pk2(res[8], res[9]); o1.y = pk2(res[10], res[11]); o1.z = pk2(res[12], res[13]); o1.w = pk2(res[14], res[15]);
    bf16* op = WcT + (size_t)n * PWD + g * 128 + c0; *(u32x4*)op = o0; *(u32x4*)(op + 8) = o1;
}
__device__ __forceinline__ void ada_item(const float* __restrict__ cnd, const float* __restrict__ cctx, const float* __restrict__ w_ada, float* MODP, int item, int lane) {
    const int cb = item % 96, kc = item / 96, col = cb * 64 + lane, kb = kc * 64;
    float wv[64];
    const float* wp = w_ada + (size_t)kb * MODW + col;
#pragma unroll
    for (int kk = 0; kk < 64; ++kk) wv[kk] = wp[(size_t)kk * MODW];
    float sv[9], acc[9];
#pragma unroll
    for (int b = 0; b < 9; ++b) { const float x = (b < 8) ? cnd[b * DM + kb + lane] : cctx[kb + lane]; sv[b] = x / (1.f + expf(-x)); acc[b] = 0.f; }
#pragma unroll
    for (int kk = 0; kk < 64; ++kk) {
#pragma unroll
        for (int b = 0; b < 9; ++b) acc[b] += __int_as_float(__builtin_amdgcn_readlane(__float_as_int(sv[b]), kk)) * wv[kk]; }
#pragma unroll
    for (int b = 0; b < 9; ++b) MODP[((size_t)kc * 9 + b) * MODW + col] = acc[b];
}

template <int U> __device__ __forceinline__ void norm_rows_bf16(const float* src0, bf16* dst0, int r, int rend, int rstride, const f32x4 (&gs)[4], const f32x4 (&sh)[4], int lane) {
    for (; r < rend; r += U * rstride) {
        f32x4 v[U][4];
#pragma unroll
        for (int u = 0; u < U; ++u) if (r + u * rstride < rend) {
#pragma unroll
            for (int j = 0; j < 4; ++j) v[u][j] = *(const f32x4*)(src0 + (size_t)(r + u * rstride) * DM + 4 * lane + 256 * j); }
#pragma unroll
        for (int u = 0; u < U; ++u) if (r + u * rstride < rend) {
            float ss = 0.f;
#pragma unroll
            for (int j = 0; j < 4; ++j) ss += (v[u][j].x * v[u][j].x + v[u][j].y * v[u][j].y) + (v[u][j].z * v[u][j].z + v[u][j].w * v[u][j].w);
            const float rstd = rsqrtf(wave_sum(ss) * (1.f / DM) + EPS);
            bf16* dst = dst0 + (size_t)(r + u * rstride) * DM;
#pragma unroll
            for (int j = 0; j < 4; ++j) { const f32x4 o = v[u][j] * rstd * gs[j] + sh[j]; u32x2 w; w.x = pk2(o.x, o.y); w.y = pk2(o.z, o.w); *(u32x2*)(dst + 4 * lane + 256 * j) = w; } }
    }
}
__device__ __forceinline__ void p1_norm(LAS unsigned char* lds, const float* __restrict__ x, const float* __restrict__ ctx, const float* __restrict__ gain, const float* __restrict__ b_ada, const float* MODP,
                                         bf16* H, bf16* HC, int bx, int G, int tid, int wave, int lane) {
    LAS float* tab = (LAS float*)lds;
    const int total = MT + MCX, per = (total + G - 1) / G, r1 = ((bx + 1) * per < total) ? (bx + 1) * per : total;
    int r = bx * per;
    while (r < r1) {
        const int b = (r < MT) ? (r >> 11) : 8, bend = (b < 8) ? (b + 1) * SL : total, rend = (r1 < bend) ? r1 : bend;
        {   const int col = 2 * tid; f32x2_t s = *(const f32x2_t*)(b_ada + col), c = *(const f32x2_t*)(b_ada + DM + col);
#pragma unroll
            for (int kc = 0; kc < NKC; ++kc) { s += *(const f32x2_t*)(MODP + ((size_t)kc * 9 + b) * MODW + col); c += *(const f32x2_t*)(MODP + ((size_t)kc * 9 + b) * MODW + DM + col); }
            const f32x2_t g = *(const f32x2_t*)(gain + col);
            tab[col] = g.x * (1.f + c.x); tab[col + 1] = g.y * (1.f + c.y); tab[DM + col] = s.x; tab[DM + col + 1] = s.y; }
        __syncthreads();
        f32x4 gs[4], sh[4];
#pragma unroll
        for (int j = 0; j < 4; ++j) { gs[j] = *(const LAS f32x4*)(tab + 4 * lane + 256 * j); sh[j] = *(const LAS f32x4*)(tab + DM + 4 * lane + 256 * j); }
        if (b < 8) norm_rows_bf16<3>(x, H, r + wave, rend, NWAVES, gs, sh, lane);
        else norm_rows_bf16<3>(ctx - (size_t)MT * DM, HC - (size_t)MT * DM, r + wave, rend, NWAVES, gs, sh, lane);
        __syncthreads();
        r = rend;
    }
}
__device__ __forceinline__ void p8_norm(const float* x1, const float* __restrict__ gain, const float* MOD, bf16* H2, int bx, int G, int wave, int lane) {
    const int per = (MT + G - 1) / G, r1 = ((bx + 1) * per < MT) ? (bx + 1) * per : MT;
    int r = bx * per;
    while (r < r1) {
        const int b = r >> 11, bend = (b + 1) * SL, rend = (r1 < bend) ? r1 : bend;
        f32x4 gs[4], sh[4];
#pragma unroll
        for (int j = 0; j < 4; ++j) { const int col = 4 * lane + 256 * j;
            const f32x4 s = *(const f32x4*)(MOD + (size_t)b * MODW + 3 * DM + col), c = *(const f32x4*)(MOD + (size_t)b * MODW + 4 * DM + col), g = *(const f32x4*)(gain + col);
            sh[j] = s; gs[j] = g * (c + 1.0f); }
        norm_rows_bf16<4>(x1, H2, r + wave, rend, NWAVES, gs, sh, lane);
        r = rend;
    }
}
__device__ __forceinline__ void p11_norm(float* out, const float* __restrict__ gain, int gw, int NGW, int lane) {
    f32x4 g[4];
#pragma unroll
    for (int j = 0; j < 4; ++j) g[j] = *(const f32x4*)(gain + 4 * lane + 256 * j);
    constexpr int U = 4;
    for (int r = gw; r < MT; r += U * NGW) {
        f32x4 v[U][4];
#pragma unroll
        for (int u = 0; u < U; ++u) if (r + u * NGW < MT) {
#pragma unroll
            for (int j = 0; j < 4; ++j) v[u][j] = *(const f32x4*)(out + (size_t)(r + u * NGW) * DM + 4 * lane + 256 * j); }
#pragma unroll
        for (int u = 0; u < U; ++u) if (r + u * NGW < MT) {
            float ss = 0.f;
#pragma unroll
            for (int j = 0; j < 4; ++j) ss += (v[u][j].x * v[u][j].x + v[u][j].y * v[u][j].y) + (v[u][j].z * v[u][j].z + v[u][j].w * v[u][j].w);
            const float rstd = rsqrtf(wave_sum(ss) * (1.f / DM) + EPS);
            float* p = out + (size_t)(r + u * NGW) * DM;
#pragma unroll
            for (int j = 0; j < 4; ++j) *(f32x4*)(p + 4 * lane + 256 * j) = v[u][j] * rstd * g[j]; }
    }
}

__device__ __forceinline__ int vt_off(int v, int j) { return v * 272 + ((((j >> 3) ^ (v >> 3)) & 15) << 4) + (j & 7) * 2; }
__device__ __forceinline__ void stage_vt(LAS unsigned char* vt, const bf16* vbase, int ld, int tid) {
    const int vseg = tid & 15, j0 = (tid >> 4) * 4;
    u32x4 r[4];
#pragma unroll
    for (int jj = 0; jj < 4; ++jj) r[jj] = *(const u32x4*)(vbase + (size_t)(j0 + jj) * ld + vseg * 8);
#pragma unroll
    for (int e2 = 0; e2 < 4; ++e2) {
        const unsigned a0 = r[0][e2], a1 = r[1][e2], a2 = r[2][e2], a3 = r[3][e2];
        u32x2 lo, hi; lo.x = (a0 & 0xffffu) | (a1 << 16); lo.y = (a2 & 0xffffu) | (a3 << 16); hi.x = (a0 >> 16) | (a1 & 0xffff0000u); hi.y = (a2 >> 16) | (a3 & 0xffff0000u);
        const int v = vseg * 8 + 2 * e2;
        *(LAS u32x2*)(vt + vt_off(v, j0)) = lo; *(LAS u32x2*)(vt + vt_off(v + 1, j0)) = hi;
    }
}
__device__ __forceinline__ void rope_cs(int tok, int f, float& cs, float& sn) {
    const float pos = (float)((f < 16) ? (tok >> 6) : (tok & 63));
    const float ang = pos * ex2(-(float)(f & 15) * 0.8304820237218406f);
    cs = __cosf(ang); sn = __sinf(ang);
}
__device__ __forceinline__ void a_item(LAS unsigned char* lds, const bf16* Z, const bf16* ZC, bf16* AT, float lgf2, float lgb2, int b, int h, int pos, int tid, int wave, int lane) {
    LAS unsigned char* Vt = lds; LAS unsigned char* Kt = lds + 34816;
    const bool lat = pos >= 2; const int c = pos - 2;
    const bf16* kbase = lat ? Z + ((size_t)b * SL + c * 128) * INW + K_OFF + h * DK : ZC + ((size_t)b * LCX + pos * 128) * 1536 + h * DK;
    const bf16* vbase = lat ? Z + ((size_t)b * SL + c * 128) * INW + V_OFF + h * DV : ZC + ((size_t)b * LCX + pos * 128) * 1536 + 512 + h * DV;
    const int ld = lat ? INW : 1536;
    stage_vt(Vt, vbase, ld, tid);
    if (tid < 256) {
        const int tt = tid & 127, dir = tid >> 7, ds = tt & 3, j0 = (tt >> 2) * 4, d0 = ds * 8;
        const float lg2 = dir ? lgb2 : lgf2;
        unsigned p1[8][2], p2[8][2];
#pragma unroll
        for (int jp = 0; jp < 2; ++jp) {
            float o1[2][8], o2[2][8];
#pragma unroll
            for (int q = 0; q < 2; ++q) { const int j = j0 + 2 * jp + q;
                float x1[8], x2[8]; unpack8(*(const u32x4*)(kbase + (size_t)j * ld + d0), x1); unpack8(*(const u32x4*)(kbase + (size_t)j * ld + 32 + d0), x2);
                const float dec = ex2(lg2 * (float)(dir ? j : 127 - j)) * 0.125f;
#pragma unroll
                for (int e = 0; e < 8; ++e) {
                    float a = x1[e], bb = x2[e];
                    if (lat) { float cs, sn; rope_cs(c * 128 + j, d0 + e, cs, sn); const float t1 = a * cs - bb * sn, t2 = a * sn + bb * cs; a = t1; bb = t2; }
                    o1[q][e] = a * dec; o2[q][e] = bb * dec; } }
#pragma unroll
            for (int e = 0; e < 8; ++e) { p1[e][jp] = pk2(o1[0][e], o1[1][e]); p2[e][jp] = pk2(o2[0][e], o2[1][e]); }
        }
#pragma unroll
        for (int e = 0; e < 8; ++e) { u32x2 w1, w2; w1.x = p1[e][0]; w1.y = p1[e][1]; w2.x = p2[e][0]; w2.y = p2[e][1];
            *(LAS u32x2*)(Kt + vt_off(dir * 64 + d0 + e, j0)) = w1; *(LAS u32x2*)(Kt + vt_off(dir * 64 + 32 + d0 + e, j0)) = w2; }
    }
    __syncthreads();
    const int fr = lane & 15, fq = lane >> 4;
    f32x4 acc[8];
#pragma unroll
    for (int ct = 0; ct < 8; ++ct) acc[ct] = (f32x4){0.f, 0.f, 0.f, 0.f};
#pragma unroll
    for (int ks = 0; ks < 4; ++ks) {
        const bf16x8 a = *(const LAS bf16x8*)(Vt + vt_off(16 * wave + fr, 32 * ks + 8 * fq));
#pragma unroll
        for (int ct = 0; ct < 8; ++ct) { const bf16x8 bb = *(const LAS bf16x8*)(Kt + vt_off(16 * ct + fr, 32 * ks + 8 * fq)); acc[ct] = __builtin_amdgcn_mfma_f32_16x16x32_bf16(a, bb, acc[ct], 0, 0, 0); }
    }
    bf16* ob = AT + ((size_t)((b * NH + h) * NPOS + pos)) * 16384;
#pragma unroll
    for (int ct = 0; ct < 8; ++ct)
#pragma unroll
        for (int r = 0; r < 4; ++r) ob[(16 * wave + 4 * fq + r) * 128 + 16 * ct + fr] = f2bf(acc[ct][r]);
    __syncthreads();
}
__device__ __forceinline__ void pool_item(LAS unsigned char* lds, const bf16* Z, bf16* Db, int b, int g, int r, int chh, int tid) {
    LAS float* cs = (LAS float*)lds;
    const int c = tid >> 3, sg = tid & 7, ch0 = g * 128 + chh * 64 + sg * 8, hw = 1 << g;
    const int rlo = (r - hw > 0) ? r - hw : 0, rhi = (r + hw < 32) ? r + hw : 32, clo = (c - hw > 0) ? c - hw : 0, chi = (c + hw < 64) ? c + hw : 64;
    float sum[8], own[8];
#pragma unroll
    for (int e = 0; e < 8; ++e) { sum[e] = 0.f; own[e] = 0.f; }
    for (int rr = rlo; rr < rhi; ++rr) {
        float x[8]; unpack8(*(const u32x4*)(Z + ((size_t)b * SL + rr * 64 + c) * INW + ch0), x);
#pragma unroll
        for (int e = 0; e < 8; ++e) { sum[e] += x[e]; if (rr == r) own[e] = x[e]; }
    }
    *(LAS f32x4*)(cs + c * 68 + sg * 8) = (f32x4){sum[0], sum[1], sum[2], sum[3]}; *(LAS f32x4*)(cs + c * 68 + sg * 8 + 4) = (f32x4){sum[4], sum[5], sum[6], sum[7]};
    __syncthreads();
    f32x4 h0 = (f32x4){0.f, 0.f, 0.f, 0.f}, h1 = h0;
    for (int cc = clo; cc < chi; ++cc) { h0 += *(const LAS f32x4*)(cs + cc * 68 + sg * 8); h1 += *(const LAS f32x4*)(cs + cc * 68 + sg * 8 + 4); }
    const float inv = 1.f / (float)((rhi - rlo) * (chi - clo));
    float o[8];
#pragma unroll
    for (int e = 0; e < 4; ++e) { o[e] = h0[e] * inv - own[e]; o[4 + e] = h1[e] * inv - own[4 + e]; }
    *(u32x4*)(Db + ((size_t)b * SL + r * 64 + c) * PWD + ch0) = pack8(o);
    __syncthreads();
}
__device__ __forceinline__ void scan_item(const bf16* AT, bf16* ST, float lgf2, float lgb2, int bh, int q, int tid) {
    const int e0 = q * 4096 + tid * 8; const bool dirb = ((tid & 15) >= 8);
    const float cd = ex2((dirb ? lgb2 : lgf2) * 128.f);
    const bf16* ab = AT + (size_t)bh * NPOS * 16384 + e0; bf16* sb = ST + (size_t)bh * NCH * 16384 + e0;
    float S[8];
#pragma unroll
    for (int e = 0; e < 8; ++e) S[e] = 0.f;
#pragma unroll
    for (int s = 0; s < NPOS; ++s) {
        if (s >= 2) { const int cc = dirb ? 17 - s : s - 2; *(u32x4*)(sb + (size_t)cc * 16384) = pack8(S); }
        if (s < NPOS - 1) { const int posr = dirb ? (s < 2 ? 1 - s : 19 - s) : s; float a[8]; unpack8(*(const u32x4*)(ab + (size_t)posr * 16384), a);
#pragma unroll
            for (int e = 0; e < 8; ++e) S[e] = cd * S[e] + a[e]; }
    }
}
__device__ __forceinline__ void r3_item(LAS unsigned char* lds, const bf16* Z, const bf16* ST, bf16* YN, const float* __restrict__ gnw, float lgf2, float lgb2,
                                         int b, int h, int c, int tid, int wave, int lane) {
    LAS unsigned char* Qs = lds; LAS unsigned char* Ks = lds + 18432; LAS unsigned char* Vt = lds + 36864; LAS unsigned char* Ps = lds + 71680; LAS unsigned char* Ss = lds + 106496;
    const size_t grow0 = (size_t)b * SL + c * 128;
    {
        const int row = tid >> 2, ds = tid & 3, d0 = ds * 8, tok = c * 128 + row;
        const bf16* zr = Z + (grow0 + row) * INW + h * DK + d0;
        float q1[8], q2[8], k1[8], k2[8];
        unpack8(*(const u32x4*)(zr + Q_OFF), q1); unpack8(*(const u32x4*)(zr + Q_OFF + 32), q2); unpack8(*(const u32x4*)(zr + K_OFF), k1); unpack8(*(const u32x4*)(zr + K_OFF + 32), k2);
        float qa[8], qb[8], ka[8], kb[8];
#pragma unroll
        for (int e = 0; e < 8; ++e) { float cs, sn; rope_cs(tok, d0 + e, cs, sn);
            qa[e] = q1[e] * cs - q2[e] * sn; qb[e] = q1[e] * sn + q2[e] * cs;
            ka[e] = (k1[e] * cs - k2[e] * sn) * 0.125f; kb[e] = (k1[e] * sn + k2[e] * cs) * 0.125f; }
        *(LAS u32x4*)(Qs + row * 144 + d0 * 2) = pack8(qa); *(LAS u32x4*)(Qs + row * 144 + (32 + d0) * 2) = pack8(qb);
        *(LAS u32x4*)(Ks + row * 144 + d0 * 2) = pack8(ka); *(LAS u32x4*)(Ks + row * 144 + (32 + d0) * 2) = pack8(kb);
    }
    stage_vt(Vt, Z + grow0 * INW + V_OFF + h * DV, INW, tid);
    {   const bf16* sp = ST + ((size_t)((b * NH + h) * NCH + c)) * 16384;
#pragma unroll
        for (int i = 0; i < 4; ++i) { const int idx = tid + NTHR * i, v = idx >> 4, seg = idx & 15; *(LAS u32x4*)(Ss + v * 272 + seg * 16) = *(const u32x4*)(sp + v * 128 + seg * 8); } }
    __syncthreads();
    const int fr = lane & 15, fq = lane >> 4, i0 = 16 * wave;
    f32x4 s[8];
#pragma unroll
    for (int ct = 0; ct < 8; ++ct) s[ct] = (f32x4){0.f, 0.f, 0.f, 0.f};
#pragma unroll
    for (int ks = 0; ks < 2; ++ks) {
        const bf16x8 a = *(const LAS bf16x8*)(Qs + (i0 + fr) * 144 + (32 * ks + 8 * fq) * 2);
#pragma unroll
        for (int ct = 0; ct < 8; ++ct) { const bf16x8 bb = *(const LAS bf16x8*)(Ks + (16 * ct + fr) * 144 + (32 * ks + 8 * fq) * 2); s[ct] = __builtin_amdgcn_mfma_f32_16x16x32_bf16(a, bb, s[ct], 0, 0, 0); }
    }
#pragma unroll
    for (int ct = 0; ct < 8; ++ct)
#pragma unroll
        for (int r = 0; r < 4; ++r) { const int i = i0 + 4 * fq + r, j = 16 * ct + fr, df = i - j;
            const float dv = ex2(df >= 0 ? lgf2 * (float)df : lgb2 * (float)(-df));
            *(LAS bf16*)(Ps + i * 272 + j * 2) = f2bf(s[ct][r] * dv); }
    __syncthreads();
    f32x4 o[8];
#pragma unroll
    for (int vt = 0; vt < 8; ++vt) o[vt] = (f32x4){0.f, 0.f, 0.f, 0.f};
#pragma unroll
    for (int ks = 0; ks < 4; ++ks) {
        const bf16x8 a = *(const LAS bf16x8*)(Ps + (i0 + fr) * 272 + (32 * ks + 8 * fq) * 2);
#pragma unroll
        for (int vt = 0; vt < 8; ++vt) { const bf16x8 bb = *(const LAS bf16x8*)(Vt + vt_off(16 * vt + fr, 32 * ks + 8 * fq)); o[vt] = __builtin_amdgcn_mfma_f32_16x16x32_bf16(a, bb, o[vt], 0, 0, 0); }
    }
    {   const int il = i0 + fr; const float dff = ex2(lgf2 * (float)(il + 1)), dbb = ex2(lgb2 * (float)(128 - il));
#pragma unroll
        for (int ks = 0; ks < 4; ++ks) {
            float qv[8]; unpack8(*(const LAS u32x4*)(Qs + il * 144 + (32 * (ks & 1) + 8 * fq) * 2), qv);
            const float dec = (ks < 2) ? dff : dbb;
#pragma unroll
            for (int e = 0; e < 8; ++e) qv[e] *= dec;
            const u32x4 pa = pack8(qv); const bf16x8 a = __builtin_bit_cast(bf16x8, pa);
#pragma unroll
            for (int vt = 0; vt < 8; ++vt) { const bf16x8 bb = *(const LAS bf16x8*)(Ss + (16 * vt + fr) * 272 + (32 * ks + 8 * fq) * 2); o[vt] = __builtin_amdgcn_mfma_f32_16x16x32_bf16(a, bb, o[vt], 0, 0, 0); }
        }
    }
    float gw_[8];
#pragma unroll
    for (int vt = 0; vt < 8; ++vt) gw_[vt] = gnw[h * DV + 16 * vt + fr];
#pragma unroll
    for (int r = 0; r < 4; ++r) {
        float sm = 0.f;
#pragma unroll
        for (int vt = 0; vt < 8; ++vt) sm += o[vt][r];
        sm += __shfl_xor(sm, 1); sm += __shfl_xor(sm, 2); sm += __shfl_xor(sm, 4); sm += __shfl_xor(sm, 8);
        const float mu = sm * (1.f / DV); float vs = 0.f;
#pragma unroll
        for (int vt = 0; vt < 8; ++vt) { const float d = o[vt][r] - mu; vs += d * d; }
        vs += __shfl_xor(vs, 1); vs += __shfl_xor(vs, 2); vs += __shfl_xor(vs, 4); vs += __shfl_xor(vs, 8);
        const float rstd = rsqrtf(vs * (1.f / DV) + EPS);
        const size_t row = grow0 + i0 + 4 * fq + r;
#pragma unroll
        for (int vt = 0; vt < 8; ++vt) { const int col = h * DV + 16 * vt + fr; const float gg = bf1(Z[row * INW + G_OFF + col]);
            YN[row * DM + col] = f2bf((o[vt][r] - mu) * rstd * gw_[vt] * silu_(gg)); }
    }
    __syncthreads();
}

#define XB_TMO      128
#define XB_XCNT(j)  (256  + 64 * (j))
#define XB_XSUB(j)  (1280 + 64 * (j))
#define XB_XGEN(j)  (2304 + 64 * (j))
#define XB_TOP      3328
#define XB_TOPGEN   3392
#define XCD_BAR_WORDS 3456
#define XB_SPIN_CAP (1u << 18)

__device__ __forceinline__ unsigned xb_ld(unsigned* p)              { return __hip_atomic_load(p, __ATOMIC_RELAXED, __HIP_MEMORY_SCOPE_AGENT); }
__device__ __forceinline__ unsigned xb_add(unsigned* p, unsigned v) { return __hip_atomic_fetch_add(p, v, __ATOMIC_RELAXED, __HIP_MEMORY_SCOPE_AGENT); }
__device__ __forceinline__ unsigned xb_xcc_id() { return (unsigned)__builtin_amdgcn_s_getreg((3 << 11) | 20) & 0xFu; }
#define XB_SPIN(cond, bar) do { unsigned _sp = 0; while (cond) { __builtin_amdgcn_s_sleep(1); \
    if ((++_sp & 255u) == 0u) { if (xb_ld(&(bar)[XB_TMO])) break; if (_sp > XB_SPIN_CAP) { atomicAdd(&(bar)[XB_TMO], 1u); break; } } } } while (0)

struct XcdBarrier {
    unsigned* bar; unsigned x;
    volatile LAS unsigned* st;
};

__device__ __forceinline__ XcdBarrier xcd_barrier_post(unsigned* bar, volatile LAS unsigned* st) {
    XcdBarrier b; b.bar = bar; b.x = xb_xcc_id(); b.st = st;
    if (threadIdx.x == 0) (void)xb_add(&bar[XB_XCNT(b.x)], 1u);
    return b;
}
__device__ __forceinline__ void xcd_barrier_complete(unsigned* bar, unsigned x, unsigned& nloc, unsigned& nx) {
    const unsigned G = gridDim.x * gridDim.y * gridDim.z;
    unsigned sum, cnt, mine, sp = 0u;
    for (;;) {
        sum = 0u; cnt = 0u; mine = 0u;
#pragma unroll
        for (unsigned j = 0; j < 16; ++j) { const unsigned c = xb_ld(&bar[XB_XCNT(j)]); sum += c; cnt += (c > 0u) ? 1u : 0u; mine = (j == x) ? c : mine; }
        if (sum == G) break;
        __builtin_amdgcn_s_sleep(1);
        if ((++sp & 255u) == 0u) { if (xb_ld(&bar[XB_TMO])) break; if (sp > XB_SPIN_CAP) { atomicAdd(&bar[XB_TMO], 1u); break; } }
    }
    nloc = mine > 0u ? mine : 1u; nx = cnt > 0u ? cnt : 1u;
}

__device__ __forceinline__ void xcd_barrier(const XcdBarrier& b) {
    asm volatile("s_waitcnt vmcnt(0)" ::: "memory");
    __syncthreads();
    if (threadIdx.x == 0) {
        unsigned* bar = b.bar;
        __builtin_amdgcn_s_waitcnt(0);
        unsigned nloc = b.st[0], nx = b.st[1];
        if (nloc == 0u) { xcd_barrier_complete(bar, b.x, nloc, nx); b.st[0] = nloc; b.st[1] = nx; }
        const unsigned old = xb_add(&bar[XB_XSUB(b.x)], 1u);
        const unsigned gen = old / nloc;
        if (old + 1u == (gen + 1u) * nloc) {
            __builtin_amdgcn_fence(__ATOMIC_RELEASE, "agent");
            asm volatile("s_waitcnt vmcnt(0)" ::: "memory");
            const unsigned og = xb_add(&bar[XB_TOP], 1u);
            const unsigned tg = og / nx;
            if (og + 1u == (tg + 1u) * nx) xb_add(&bar[XB_TOPGEN], 1u);
            else XB_SPIN(xb_ld(&bar[XB_TOPGEN]) == tg, bar);
            __builtin_amdgcn_fence(__ATOMIC_ACQUIRE, "agent");
            xb_add(&bar[XB_XGEN(b.x)], 1u);
            asm volatile("s_waitcnt vmcnt(0)" ::: "memory");
        } else {
            XB_SPIN(xb_ld(&bar[XB_XGEN(b.x)]) == gen, bar);
            __builtin_amdgcn_fence(__ATOMIC_ACQUIRE, "agent");
            asm volatile("s_waitcnt vmcnt(0)" ::: "memory");
        }
    }
    __syncthreads();
}

struct Args { const float* in[21]; float* out; unsigned char* ws; int ph_lo, ph_hi; };
__global__ void __launch_bounds__(NTHR) mk_fwd(Args args) {
    extern __shared__ __attribute__((aligned(16))) unsigned char lds_raw[];
    LAS unsigned char* lds = (LAS unsigned char*)lds_raw;
    cg::grid_group grid = cg::this_grid();
    const int tid = threadIdx.x, lane = tid & 63, wave = __builtin_amdgcn_readfirstlane(tid >> 6);
    const int G = gridDim.x, bx = blockIdx.x, gw = bx * NWAVES + wave, NGW = G * NWAVES;
    const float* x = args.in[0]; const float* cnd = args.in[1]; const float* ctx = args.in[2]; const float* cctx = args.in[3];
    const float* w_ada = args.in[4]; const float* b_ada = args.in[5]; const float* norm_mix = args.in[6]; const float* norm_ffn = args.in[7];
    const float* w_in = args.in[8]; const float* w_pool = args.in[9]; const float* pscale = args.in[10]; const float* dec_f = args.in[11]; const float* dec_b = args.in[12];
    const float* gn_w = args.in[13]; const float* w_pa = args.in[14]; const float* w_rb = args.in[15]; const float* w_o = args.in[16];
    const float* w_ff1 = args.in[17]; const float* w_ff3 = args.in[18]; const float* w_ff2 = args.in[19]; const float* norm_final = args.in[20];
    float* out = args.out; unsigned char* ws = args.ws;
    bf16* W13T = (bf16*)(ws + WS_W13); bf16* W2T = (bf16*)(ws + WS_W2); bf16* WcT = (bf16*)(ws + WS_WCOMB); bf16* WrbT = (bf16*)(ws + WS_WRB); bf16* WoT = (bf16*)(ws + WS_WO);
    float* MODP = (float*)(ws + WS_MODP); float* MOD = (float*)(ws + WS_MOD);
    bf16* Z = (bf16*)(ws + WS_Z); bf16* WinT = (bf16*)(ws + WS_WIN); bf16* H = (bf16*)(ws + WS_H); bf16* HC = (bf16*)(ws + WS_HC); bf16* ZC = (bf16*)(ws + WS_ZC);
    bf16* Db = (bf16*)(ws + WS_D); bf16* ST = (bf16*)(ws + WS_ST); bf16* MG = (bf16*)(ws + WS_MERGED); bf16* H2 = (bf16*)(ws + WS_H2); bf16* HMID = (bf16*)(ws + WS_HMID);
    bf16* AT = (bf16*)out; bf16* YN = (bf16*)out;
    const int lo = args.ph_lo, hi = args.ph_hi;
    const bool one_launch = (hi - lo) > 1;
    volatile LAS unsigned* xst = (volatile LAS unsigned*)(lds + LDS_BYTES - 64);
    unsigned* xbar = (unsigned*)ws;
    if (one_launch) {
        if (tid == 0) { xst[0] = 0u; xst[1] = 0u; }
        if (bx == 0) for (int i = tid; i < XCD_BAR_WORDS; i += NTHR) __hip_atomic_store(xbar + i, 0u, __ATOMIC_RELAXED, __HIP_MEMORY_SCOPE_AGENT);
        __syncthreads();
    }
    XcdBarrier xb; xb.bar = xbar; xb.x = 0; xb.st = xst;
#define IN(k) (lo <= (k) && (k) < hi)
#define SEAM(k) do { if (IN(k) && IN((k) + 1)) { if ((k) == 0) { grid.sync(); xb = xcd_barrier_post(xbar, xst); } else xcd_barrier(xb); } } while (0)

    if (IN(0)) for (int rep_ = 0; rep_ < REPS[0]; ++rep_) {
        LAS float* scr = (LAS float*)(lds + wave * 16384);
        constexpr int I_ADA = 96 * NKC, I_WC = 512, I_IN = (DM / 64) * (INW / 32), I_F1 = (DM / 64) * (DFF / 32), I_F2 = (DFF / 64) * (DM / 32), I_SQ = (DM / 64) * (DM / 32);
        constexpr int NIT = I_ADA + I_WC + I_IN + 2 * I_F1 + I_F2 + 2 * I_SQ;
        for (int it = gw; it < NIT; it += NGW) {
            int r = it;
            if (r < I_ADA) { ada_item(cnd, cctx, w_ada, MODP, r, lane); continue; } r -= I_ADA;
            if (r < I_WC) { wcomb_item(w_pool, pscale, w_pa, WcT, r, lane); continue; } r -= I_WC;
            if (r < I_IN) { transpose_item(w_in, DM, INW, WinT, 0, scr, r, lane); continue; } r -= I_IN;
            if (r < I_F1) { transpose_item(w_ff1, DM, DFF, W13T, 1, scr, r, lane); continue; } r -= I_F1;
            if (r < I_F1) { transpose_item(w_ff3, DM, DFF, W13T, 2, scr, r, lane); continue; } r -= I_F1;
            if (r < I_F2) { transpose_item(w_ff2, DFF, DM, W2T, 0, scr, r, lane); continue; } r -= I_F2;
            if (r < I_SQ) { transpose_item(w_rb, DM, DM, WrbT, 0, scr, r, lane); continue; } r -= I_SQ;
            transpose_item(w_o, DM, DM, WoT, 0, scr, r, lane);
        }
    }
    SEAM(0);
    if (IN(1)) for (int rep_ = 0; rep_ < REPS[1]; ++rep_) {
        p1_norm(lds, x, ctx, norm_mix, b_ada, MODP, H, HC, bx, G, tid, wave, lane);
        for (int i = bx * NTHR + tid; i < 9 * MODW; i += G * NTHR) { float s = b_ada[i % MODW];
#pragma unroll
            for (int kc = 0; kc < NKC; ++kc) s += MODP[(size_t)kc * 9 * MODW + i];
            MOD[i] = s; }
    }
    SEAM(1);
    if (IN(2)) for (int rep_ = 0; rep_ < REPS[2]; ++rep_) {
        pg8::Gemm g{H, WinT, HC, WinT + (size_t)K_OFF * DM, DM}; pg8::StaticOrder S; S.init(MT, INW, G, bx, MCX, 1536);
        EpiZ E{Z, ZC};
        pg8::gemm_phase<EpiZ, pg8::StaticOrder, true, true>(lds, g, S, E);
    }
    SEAM(2);
    if (IN(3)) for (int rep_ = 0; rep_ < REPS[3]; ++rep_) {
        constexpr int N_A = NB * NH * NPOS, N_P = NB * 4 * 32 * 2;
        for (int it = bx; it < N_A + N_P; it += G) {
            if (it < N_A) { const int bh = it / NPOS, pos = it % NPOS, b = bh >> 3, h = bh & 7;
                a_item(lds, Z, ZC, AT, log2_sigmoid(dec_f[h]), log2_sigmoid(dec_b[h]), b, h, pos, tid, wave, lane); }
            else { const int r_ = it - N_A, g = 3 - (r_ >> 9), rem = r_ & 511, b = rem >> 6, rr = (rem >> 1) & 31, chh = rem & 1;
                pool_item(lds, Z, Db, b, g, rr, chh, tid); }
        }
    }
    SEAM(3);
    if (IN(4)) for (int rep_ = 0; rep_ < REPS[4]; ++rep_) {
        for (int it = bx; it < NB * NH * 4; it += G) { const int bh = it >> 2, q = it & 3, h = bh & 7;
            scan_item(AT, ST, log2_sigmoid(dec_f[h]), log2_sigmoid(dec_b[h]), bh, q, tid); }
    }
    SEAM(4);
    if (IN(5)) for (int rep_ = 0; rep_ < REPS[5]; ++rep_) {
        for (int it = bx; it < NB * NH * NCH; it += G) { const int bh = it >> 4, c = it & 15, b = bh >> 3, h = bh & 7;
            r3_item(lds, Z, ST, YN, gn_w, log2_sigmoid(dec_f[h]), log2_sigmoid(dec_b[h]), b, h, c, tid, wave, lane); }
    }
    SEAM(5);
    if (IN(6)) for (int rep_ = 0; rep_ < REPS[6]; ++rep_) {
        { pg8::Gemm g{Db, WcT, Db, WcT, PWD}; pg8::StaticOrder S; S.init(MT, DM, G, bx); EpiGate<false> E{Z, GA_OFF, MG};
          pg8::gemm_phase<EpiGate<false>, pg8::StaticOrder, true, true>(lds, g, S, E); }
        { pg8::Gemm g{YN, WrbT, YN, WrbT, DM}; pg8::StaticOrder S; S.init(MT, DM, G, bx); EpiGate<true> E{Z, GB_OFF, MG};
          pg8::gemm_phase<EpiGate<true>, pg8::StaticOrder, true, true>(lds, g, S, E); }
    }
    SEAM(6);
    if (IN(7)) for (int rep_ = 0; rep_ < REPS[7]; ++rep_) {
        pg8::Gemm g{MG, WoT, MG, WoT, DM}; pg8::StaticOrder S; S.init(MT, DM, G, bx); EpiRes E{x, out, MOD, 2 * DM};
        pg8::gemm_phase<EpiRes, pg8::StaticOrder, true, true>(lds, g, S, E);
    }
    SEAM(7);
    if (IN(8)) for (int rep_ = 0; rep_ < REPS[8]; ++rep_) p8_norm(out, norm_ffn, MOD, H2, bx, G, wave, lane);
    SEAM(8);
    if (IN(9)) for (int rep_ = 0; rep_ < REPS[9]; ++rep_) {
        pg8::Gemm g{H2, W13T, H2, W13T, DM}; pg8::StaticOrder S; S.init(MT, 2 * DFF, G, bx); EpiSwiglu E{HMID};
        pg8::gemm_phase<EpiSwiglu, pg8::StaticOrder, true, true>(lds, g, S, E);
    }
    SEAM(9);
    if (IN(10)) for (int rep_ = 0; rep_ < REPS[10]; ++rep_) {
        pg8::Gemm g{HMID, W2T, HMID, W2T, DFF}; pg8::StaticOrder S; S.init(MT, DM, G, bx); EpiRes E{out, out, MOD, 5 * DM};
        pg8::gemm_phase<EpiRes, pg8::StaticOrder, true, true>(lds, g, S, E);
    }
    SEAM(10);
    if (IN(11)) p11_norm(out, norm_final, gw, NGW, lane);
#undef IN
#undef SEAM
}

extern "C" void kernel_launch(void* const* d_in, const int* in_sizes, int n_in, void* d_out, int out_size, void* d_ws, size_t ws_size, hipStream_t stream) {
    static int grid = 0;
    if (grid == 0) {
        if (n_in != 21 || out_size != MT * DM || ws_size < WS_END) { fprintf(stderr, "kernel_launch: unexpected problem (n_in %d, out %d, ws %zu)\n", n_in, out_size, ws_size); grid = -1; return; }
        int dev = 0, cus = 0, per_cu = 0;
        (void)hipGetDevice(&dev); (void)hipDeviceGetAttribute(&cus, hipDeviceAttributeMultiprocessorCount, dev);
        if (hipFuncSetAttribute((const void*)mk_fwd, hipFuncAttributeMaxDynamicSharedMemorySize, LDS_BYTES) != hipSuccess) { fprintf(stderr, "kernel_launch: hipFuncSetAttribute failed\n"); grid = -1; return; }
        if (hipOccupancyMaxActiveBlocksPerMultiprocessor(&per_cu, (const void*)mk_fwd, NTHR, LDS_BYTES) != hipSuccess || per_cu < 1) per_cu = 1;
        (void)hipGetLastError();
        if (cus <= 0) cus = 256;
        grid = cus * per_cu;
    }
    if (grid < 0) return;
    Args a{};
    for (int i = 0; i < 21; ++i) a.in[i] = (const float*)d_in[i];
    a.out = (float*)d_out; a.ws = (unsigned char*)d_ws;
#if MK_PER_PHASE
    for (int p = 0; p < NPHASE; ++p) { a.ph_lo = p; a.ph_hi = p + 1; hipLaunchKernelGGL(mk_fwd, dim3(grid), dim3(NTHR), LDS_BYTES, stream, a); }
#else
    a.ph_lo = 0; a.ph_hi = NPHASE;
    void* kargs[] = {(void*)&a};
    hipError_t e = hipLaunchCooperativeKernel((const void*)mk_fwd, dim3(grid), dim3(NTHR), kargs, LDS_BYTES, stream);
    if (e != hipSuccess) fprintf(stderr, "kernel_launch: cooperative launch failed: %s (grid %d)\n", hipGetErrorString(e), grid);
#endif
}
```

```cpp
#include <hip/hip_runtime.h>
#include <hip/hip_cooperative_groups.h>
#include <cstdio>
#include <cstdint>
namespace cg = cooperative_groups;

#ifndef MK_PER_PHASE
#define MK_PER_PHASE 0
#endif

namespace pg8 {
#define PG8_LAS __attribute__((address_space(3)))
typedef unsigned short bf16_t;
typedef short bf16x8 __attribute__((ext_vector_type(8)));
typedef float f32x4 __attribute__((ext_vector_type(4)));
typedef unsigned u32x4 __attribute__((ext_vector_type(4)));
constexpr int BM = 256, BK = 64, HALF = 128, HTB = HALF * BK * 2  , STAGE_BYTES = 8 * HTB, NXCD = 8, WGM = 8;

__host__ __device__ __forceinline__ int lds_byte(int r, int c) { const int st = (r >> 4) * 2 + (c >> 5), rr = r & 15, cc = c & 31, ob = rr * 64 + cc * 2; return st * 1024 + (ob ^ (((ob >> 9) & 1) << 5)); }
__host__ __device__ __forceinline__ void stage_rc(int b, int& R, int& C) { const int st = b / 1024, sb = b % 1024, swz = sb ^ (((sb >> 9) & 1) << 5); R = (st >> 1) * 16 + swz / 64; C = (st & 1) * 32 + (swz % 64) / 2; }
__host__ __device__ __forceinline__ int perm32(int rho) { const int n = rho >> 4, i = rho & 15; return 8 * (i >> 2) + 4 * n + (i & 3); }

struct Unit { int pm, pn, g; };
struct Gemm { const bf16_t* A; const bf16_t* Bt; const bf16_t* A2; const bf16_t* Bt2; int K;
    __device__ __forceinline__ const char* abase(const Unit& u) const { return (const char*)(u.g ? A2 : A) + (size_t)u.pm * (size_t)(2 * HALF) * K * 2; }
    __device__ __forceinline__ const char* bbase(const Unit& u) const { return (const char*)(u.g ? Bt2 : Bt) + (size_t)u.pn * (size_t)(2 * HALF) * K * 2; } };

struct StaticOrder {
    int nM, nN, nwg, G, c;
    int n2M, n2N;
    __host__ __device__ void init(int M, int N, int G_, int c_, int M2 = 0, int N2 = 0) { nM = M / BM; nN = N / BM; nwg = nM * nN; G = G_; c = c_; n2M = M2 / BM; n2N = N2 / BM; }
    __host__ __device__ bool next(int i, Unit& u) const {
        const long L = (long)i * G + c; u.g = 0;
        if (L >= nwg) { const long j = L - nwg; if (j >= (long)n2M * n2N) return false; u.g = 1; u.pm = (int)(j % n2M); u.pn = (int)(j / n2M); return true; }
        int wgid = (int)L; { const int q = nwg / NXCD, r = nwg % NXCD, xcd = wgid % NXCD, off = wgid / NXCD; wgid = (xcd < r ? xcd * (q + 1) : r * (q + 1) + (xcd - r) * q) + off; }
        const int nig = WGM * nN, gid = wgid / nig, fm = gid * WGM, gsz = (nM - fm) < WGM ? (nM - fm) : WGM;
        u.pm = fm + ((wgid % nig) % gsz); u.pn = (wgid % nig) / gsz; return true;
    }
    __device__ __forceinline__ void a_ready(const Unit&) const {}
    __device__ __forceinline__ void done(const Unit&) const {}
};

__device__ __forceinline__ unsigned cvt_pk_bf16(float lo, float hi) { unsigned r; asm volatile("v_cvt_pk_bf16_f32 %0, %1, %2" : "=v"(r) : "v"(lo), "v"(hi)); return r; }


template <class Epi, class Sched, bool ALIGN_EPI = false, bool SP2 = false>
__device__ __forceinline__ void gemm_phase(PG8_LAS unsigned char* lds, const Gemm g, const Sched& S, const Epi& E) {
    const int tid = threadIdx.x, wid = __builtin_amdgcn_readfirstlane(tid >> 6), lane = tid & 63, wr = wid >> 2, wc = wid & 3, fr = lane & 15, fq = lane >> 4;
    const int K = g.K, nt = K / BK;
    unsigned voffA[2], voffB[2];
#pragma unroll
    for (int i = 0; i < 2; ++i) { int R, C; stage_rc(tid * 16 + i * 8192, R, C); const int Rb = Epi::PERM ? ((R & ~31) + perm32(R & 31)) : R;
        voffA[i] = (unsigned)(R * K + C) * 2u; voffB[i] = (unsigned)(Rb * K + C) * 2u; }
    const size_t kstep = (size_t)(BK * 2);
    const size_t hstep = (size_t)HALF * K * 2;
    const unsigned ldsw = (unsigned)wid * 1024u;
    const int aoff = lds_byte(wr * 64 + fr, fq * 8), boff = lds_byte(wc * 32 + fr, fq * 8);
#define PG8_SA(b, h) (((b) * 2 + (h)) * HTB)
#define PG8_SB(b, h) ((4 + (b) * 2 + (h)) * HTB)
#define PG8_STAGE(bufoff, gbase, voff) do { _Pragma("unroll") for (int _i = 0; _i < 2; ++_i) \
        __builtin_amdgcn_global_load_lds((const unsigned*)((const char*)(gbase) + (voff)[_i]), (PG8_LAS unsigned*)(lds + (bufoff) + ldsw + _i * 8192), 16, 0, 0); } while (0)
#define PG8_LDA(dst, b, h) do { _Pragma("unroll") for (int m = 0; m < 4; ++m) _Pragma("unroll") for (int k = 0; k < 2; ++k) dst[m][k] = *(const PG8_LAS bf16x8*)(lds + PG8_SA(b, h) + aoff + m * 2048 + k * 1024); } while (0)
#define PG8_LDB(dst, b, h) do { _Pragma("unroll") for (int n = 0; n < 2; ++n) _Pragma("unroll") for (int k = 0; k < 2; ++k) dst[n][k] = *(const PG8_LAS bf16x8*)(lds + PG8_SB(b, h) + boff + n * 2048 + k * 1024); } while (0)
#define PG8_MMA(ai, bj, At, Bt) do { __builtin_amdgcn_s_setprio(1); _Pragma("unroll") for (int m = 0; m < 4; ++m) _Pragma("unroll") for (int n = 0; n < 2; ++n) _Pragma("unroll") for (int k = 0; k < 2; ++k) \
        acc[ai][bj][m][n] = __builtin_amdgcn_mfma_f32_16x16x32_bf16(Bt[n][k], At[m][k], acc[ai][bj][m][n], 0, 0, 0); __builtin_amdgcn_s_setprio(0); } while (0)
#define PG8_WAIT_V(n) asm volatile("s_waitcnt vmcnt(" #n ")" ::: "memory")
#define PG8_WAIT_L(n) asm volatile("s_waitcnt lgkmcnt(" #n ")" ::: "memory")
#define PG8_BAR __builtin_amdgcn_s_barrier()
#define PG8_SCHED __builtin_amdgcn_sched_barrier(0)
    Unit cur, nxt; int ui = 0;
    if (!S.next(0, cur)) return;
    f32x4 acc[2][2][4][2];
#pragma unroll
    for (int a = 0; a < 2; ++a)
#pragma unroll
        for (int b = 0; b < 2; ++b)
#pragma unroll
            for (int m = 0; m < 4; ++m)
#pragma unroll
                for (int n = 0; n < 2; ++n) acc[a][b][m][n] = (f32x4){0.f, 0.f, 0.f, 0.f};
    bf16x8 At[4][2], B0[2][2], B1[2][2];
    const char* cA = g.abase(cur); const char* cB = g.bbase(cur);
    S.a_ready(cur);
    if constexpr (SP2) {
        PG8_STAGE(PG8_SB(0, 0), cB, voffB); PG8_STAGE(PG8_SB(0, 1), cB + hstep, voffB); PG8_STAGE(PG8_SA(0, 0), cA, voffA); PG8_STAGE(PG8_SA(0, 1), cA + hstep, voffA);
        if (wr == 1) PG8_BAR;
        PG8_WAIT_V(2); PG8_BAR;
        PG8_STAGE(PG8_SB(1, 0), cB + kstep, voffB); PG8_STAGE(PG8_SA(1, 0), cA + kstep, voffA); PG8_STAGE(PG8_SB(1, 1), cB + hstep + kstep, voffB);
        PG8_WAIT_V(6); PG8_BAR;
    } else {
        PG8_STAGE(PG8_SB(0, 0), cB, voffB); PG8_STAGE(PG8_SA(0, 0), cA, voffA); PG8_STAGE(PG8_SB(0, 1), cB + hstep, voffB); PG8_STAGE(PG8_SA(0, 1), cA + hstep, voffA);
        if (wr == 1) PG8_BAR;
        PG8_WAIT_V(4); PG8_BAR;
        PG8_STAGE(PG8_SB(1, 0), cB + kstep, voffB); PG8_STAGE(PG8_SA(1, 0), cA + kstep, voffA); PG8_STAGE(PG8_SB(1, 1), cB + hstep + kstep, voffB);
        PG8_WAIT_V(6); PG8_BAR;
    }
    for (;;) {
        const bool has_next = S.next(ui + 1, nxt);
        const char* nA = has_next ? g.abase(nxt) : cA; const char* nB = has_next ? g.bbase(nxt) : cB;
        for (int t = 0; t < nt; t += 2) {
            const bool last = (t == nt - 2);
            const char* a1 = cA + (size_t)(t + 1) * kstep;
            const char* a2 = last ? nA : cA + (size_t)(t + 2) * kstep; const char* b2 = last ? nB : cB + (size_t)(t + 2) * kstep;
            const char* a3 = a2 + kstep; const char* b3 = b2 + kstep;
            if (last && has_next) S.a_ready(nxt);
            if constexpr (SP2) {
            PG8_LDB(B0, 0, 0); PG8_LDB(B1, 0, 1); PG8_SCHED; PG8_LDA(At, 0, 0); PG8_STAGE(PG8_SA(1, 1), a1 + hstep, voffA);
            PG8_WAIT_V(8); PG8_WAIT_L(0); PG8_BAR; PG8_MMA(0, 0, At, B0); PG8_MMA(0, 1, At, B1); PG8_BAR; PG8_SCHED;
            PG8_LDA(At, 0, 1); PG8_STAGE(PG8_SB(0, 0), b2, voffB); PG8_STAGE(PG8_SB(0, 1), b2 + hstep, voffB); PG8_STAGE(PG8_SA(0, 0), a2, voffA);
            PG8_WAIT_V(8); PG8_WAIT_L(0); PG8_BAR; PG8_MMA(1, 0, At, B0); PG8_MMA(1, 1, At, B1); PG8_BAR; PG8_SCHED;
            PG8_LDB(B0, 1, 0); PG8_LDB(B1, 1, 1); PG8_SCHED; PG8_LDA(At, 1, 0); PG8_STAGE(PG8_SA(0, 1), a2 + hstep, voffA);
            PG8_WAIT_V(8); PG8_WAIT_L(0); PG8_BAR; PG8_MMA(0, 0, At, B0); PG8_MMA(0, 1, At, B1); PG8_BAR; PG8_SCHED;
            PG8_LDA(At, 1, 1); PG8_STAGE(PG8_SB(1, 0), b3, voffB); PG8_STAGE(PG8_SB(1, 1), b3 + hstep, voffB); PG8_STAGE(PG8_SA(1, 0), a3, voffA);
            PG8_WAIT_V(8); PG8_WAIT_L(0); PG8_BAR; PG8_MMA(1, 0, At, B0); PG8_MMA(1, 1, At, B1); PG8_BAR; PG8_SCHED;
            } else {
            PG8_LDB(B0, 0, 0); PG8_SCHED; PG8_LDA(At, 0, 0); PG8_STAGE(PG8_SA(1, 1), a1 + hstep, voffA);
            PG8_WAIT_L(8); PG8_BAR; PG8_WAIT_L(0); PG8_MMA(0, 0, At, B0); PG8_BAR; PG8_SCHED;
            PG8_LDB(B1, 0, 1); PG8_STAGE(PG8_SB(0, 0), b2, voffB);
            PG8_BAR; PG8_WAIT_L(0); PG8_MMA(0, 1, At, B1); PG8_BAR;
            PG8_LDA(At, 0, 1); PG8_STAGE(PG8_SA(0, 0), a2, voffA);
            PG8_BAR; PG8_WAIT_L(0); PG8_MMA(1, 0, At, B0); PG8_BAR; PG8_SCHED;
            PG8_STAGE(PG8_SB(0, 1), b2 + hstep, voffB);
            PG8_WAIT_V(6); PG8_BAR; PG8_MMA(1, 1, At, B1); PG8_BAR;
            PG8_LDB(B0, 1, 0); PG8_SCHED; PG8_LDA(At, 1, 0); PG8_STAGE(PG8_SA(0, 1), a2 + hstep, voffA);
            PG8_WAIT_L(8); PG8_BAR; PG8_WAIT_L(0); PG8_MMA(0, 0, At, B0); PG8_BAR; PG8_SCHED;
            PG8_LDB(B1, 1, 1); PG8_STAGE(PG8_SB(1, 0), b3, voffB);
            PG8_BAR; PG8_WAIT_L(0); PG8_MMA(0, 1, At, B1); PG8_BAR;
            PG8_LDA(At, 1, 1); PG8_STAGE(PG8_SA(1, 0), a3, voffA);
            PG8_BAR; PG8_WAIT_L(0); PG8_MMA(1, 0, At, B0); PG8_BAR; PG8_SCHED;
            PG8_STAGE(PG8_SB(1, 1), b3 + hstep, voffB);
            PG8_WAIT_V(6); PG8_BAR; PG8_MMA(1, 1, At, B1); PG8_BAR;
            }
        }
        if constexpr (ALIGN_EPI) { if (wr == 0) PG8_BAR; }
        if constexpr (!Epi::AFTER_DRAIN) { E(acc, cur, wr, wc, fr, fq); S.done(cur); }
        if (!has_next) break;
#pragma unroll
        for (int a = 0; a < 2; ++a)
#pragma unroll
            for (int b = 0; b < 2; ++b)
#pragma unroll
                for (int m = 0; m < 4; ++m)
#pragma unroll
                    for (int n = 0; n < 2; ++n) acc[a][b][m][n] = (f32x4){0.f, 0.f, 0.f, 0.f};
        cur = nxt; cA = nA; cB = nB; ++ui;
        if constexpr (ALIGN_EPI) { if (wr == 1) PG8_BAR; }
    }
    PG8_WAIT_V(0);
    if constexpr (!ALIGN_EPI) { if (wr == 0) PG8_BAR; }
    PG8_BAR;
    if constexpr (Epi::AFTER_DRAIN) { E.fused(acc, cur, wr, wc, fr, fq, lds, wid, lane); S.done(cur); }
#undef PG8_SA
#undef PG8_SB
#undef PG8_STAGE
#undef PG8_LDA
#undef PG8_LDB
#undef PG8_MMA
#undef PG8_WAIT_V
#undef PG8_WAIT_L
#undef PG8_BAR
#undef PG8_SCHED
}
}

using pg8::f32x4; using pg8::bf16x8; using pg8::u32x4; using pg8::Unit;
#define LAS __attribute__((address_space(3)))
typedef unsigned short bf16;
typedef unsigned u32x2 __attribute__((ext_vector_type(2)));
typedef float f32x2_t __attribute__((ext_vector_type(2)));
typedef __bf16 bf16x2_t __attribute__((ext_vector_type(2)));
#define LDS_WAIT() asm volatile("s_waitcnt lgkmcnt(0)" ::: "memory")

constexpr int NWAVES = 8, NTHR = 512;
constexpr int DM = 1024, NB = 8, SL = 2048, MT = NB * SL, LCX = 256, MCX = NB * LCX;
constexpr int INW = 5632, DFF = 2816, PWD = 512, NH = 8, DK = 64, DV = 128;
constexpr int Q_OFF = 512, K_OFF = 1024, V_OFF = 1536, G_OFF = 2560, GA_OFF = 3584, GB_OFF = 4608;
constexpr int NPOS = 18, NCH = 16, MODW = 6 * DM, NKC = 16;
constexpr float EPS = 1e-6f, LOG2E = 1.4426950408889634f;
constexpr int LDS_BYTES = 147456;
constexpr int NPHASE = 12;
#ifndef MK_REPS
#define MK_REPS {1,1,1,1,1,1,1,1,1,1,1,1}
#endif
__device__ constexpr int REPS[NPHASE] = MK_REPS;

constexpr size_t MiB = 1u << 20;
constexpr size_t WS_W13 = 1 * MiB, WS_W2 = 12 * MiB, WS_WCOMB = 17 * MiB + MiB / 2, WS_WRB = 18 * MiB + MiB / 2, WS_WO = 20 * MiB + MiB / 2;
constexpr size_t WS_MOD = 23 * MiB + MiB / 2, WS_Z = 24 * MiB, WS_MODP = WS_Z  , WS_SA = 200 * MiB, WS_END = 256 * MiB;
constexpr size_t WS_WIN = WS_SA, WS_H = WS_SA + 11 * MiB, WS_HC = WS_SA + 43 * MiB, WS_ZC = WS_SA + 47 * MiB;
constexpr size_t WS_D = WS_SA, WS_ST = WS_SA + 16 * MiB, WS_MERGED = WS_SA + 16 * MiB, WS_H2 = WS_SA, WS_HMID = WS_Z;
static_assert(WS_ZC + (size_t)MCX * 1536 * 2 <= WS_END && WS_ST + (size_t)64 * 16 * 16384 * 2 <= WS_END && WS_Z + (size_t)MT * INW * 2 <= WS_SA, "ws map");
static_assert((size_t)64 * NPOS * 16384 * 2 <= (size_t)MT * DM * 4, "ws map 2");

__device__ __forceinline__ unsigned pk2(float lo, float hi) { f32x2_t v = {lo, hi}; bf16x2_t b = __builtin_convertvector(v, bf16x2_t); return __builtin_bit_cast(unsigned, b); }
__device__ __forceinline__ bf16 f2bf(float f) { return (bf16)(pk2(f, 0.f) & 0xffffu); }
__device__ __forceinline__ float bflo(unsigned u) { return __uint_as_float(u << 16); }
__device__ __forceinline__ float bfhi(unsigned u) { return __uint_as_float(u & 0xffff0000u); }
__device__ __forceinline__ float bf1(bf16 v) { return __uint_as_float((unsigned)v << 16); }
__device__ __forceinline__ float wave_sum(float v) {
#pragma unroll
    for (int o = 1; o < 64; o <<= 1) v += __shfl_xor(v, o);
    return v;
}
__device__ __forceinline__ float sigmoid_(float x) { return __builtin_amdgcn_rcpf(1.f + __builtin_amdgcn_exp2f(-x * LOG2E)); }
__device__ __forceinline__ float silu_(float x) { return x * sigmoid_(x); }
__device__ __forceinline__ float ex2(float x) { return __builtin_amdgcn_exp2f(x); }
__device__ __forceinline__ float log2_sigmoid(float x) { return -log1pf(expf(-x)) * LOG2E; }
__device__ __forceinline__ void unpack8(const u32x4 r, float (&f)[8]) {
    f[0] = bflo(r.x); f[1] = bfhi(r.x); f[2] = bflo(r.y); f[3] = bfhi(r.y); f[4] = bflo(r.z); f[5] = bfhi(r.z); f[6] = bflo(r.w); f[7] = bfhi(r.w);
}
__device__ __forceinline__ u32x4 pack8(const float (&f)[8]) { u32x4 o; o.x = pk2(f[0], f[1]); o.y = pk2(f[2], f[3]); o.z = pk2(f[4], f[5]); o.w = pk2(f[6], f[7]); return o; }

struct EpiZ {
    static constexpr bool PERM = true, AFTER_DRAIN = false;
    bf16* Z; bf16* ZC;
    __device__ __forceinline__ void operator()(const f32x4 (&acc)[2][2][4][2], const Unit& u, int wr, int wc, int fr, int fq) const {
        bf16* base = u.g ? ZC : Z; const int ldc = u.g ? 1536 : INW; const bool sig = (u.g == 0) && (u.pn >= GA_OFF / 256);
        const int row0 = u.pm * 256 + wr * 64 + fr, col0 = u.pn * 256 + wc * 32 + 8 * fq;
#pragma unroll
        for (int ai = 0; ai < 2; ++ai)
#pragma unroll
            for (int m = 0; m < 4; ++m) { bf16* rowp = base + (size_t)(row0 + ai * 128 + m * 16) * ldc + col0;
#pragma unroll
                for (int bj = 0; bj < 2; ++bj) { f32x4 v0 = acc[ai][bj][m][0], v1 = acc[ai][bj][m][1];
                    if (sig) {
#pragma unroll
                        for (int e = 0; e < 4; ++e) { v0[e] = sigmoid_(v0[e]); v1[e] = sigmoid_(v1[e]); } }
                    u32x4 w; w.x = pk2(v0[0], v0[1]); w.y = pk2(v0[2], v0[3]); w.z = pk2(v1[0], v1[1]); w.w = pk2(v1[2], v1[3]);
                    *(u32x4*)(rowp + bj * 128) = w; } }
    }
};
template <bool ADD> struct EpiGate {
    static constexpr bool PERM = true, AFTER_DRAIN = false;
    const bf16* Z; int goff; bf16* O;
    __device__ __forceinline__ void operator()(const f32x4 (&acc)[2][2][4][2], const Unit& u, int wr, int wc, int fr, int fq) const {
        const int row0 = u.pm * 256 + wr * 64 + fr, col0 = u.pn * 256 + wc * 32 + 8 * fq;
#pragma unroll
        for (int ai = 0; ai < 2; ++ai) {
            u32x4 gt[4][2], ov[4][2];
#pragma unroll
            for (int m = 0; m < 4; ++m)
#pragma unroll
                for (int bj = 0; bj < 2; ++bj) { const size_t row = (size_t)(row0 + ai * 128 + m * 16); const int col = col0 + bj * 128;
                    gt[m][bj] = *(const u32x4*)(Z + row * INW + goff + col); if (ADD) ov[m][bj] = *(const u32x4*)(O + row * DM + col); }
#pragma unroll
            for (int m = 0; m < 4; ++m)
#pragma unroll
                for (int bj = 0; bj < 2; ++bj) { const size_t row = (size_t)(row0 + ai * 128 + m * 16); const int col = col0 + bj * 128;
                    float g[8], o[8]; unpack8(gt[m][bj], g); if (ADD) unpack8(ov[m][bj], o);
#pragma unroll
                    for (int e = 0; e < 8; ++e) { const float a = acc[ai][bj][m][e >> 2][e & 3]; o[e] = ADD ? (o[e] + g[e] * a) : (g[e] * a); }
                    *(u32x4*)(O + row * DM + col) = pack8(o); }
        }
    }
};
struct EpiRes {
    static constexpr bool PERM = true, AFTER_DRAIN = false;
    const float* base; float* out; const float* mod; int goff;
    __device__ __forceinline__ void operator()(const f32x4 (&acc)[2][2][4][2], const Unit& u, int wr, int wc, int fr, int fq) const {
        const int row0 = u.pm * 256 + wr * 64 + fr, col0 = u.pn * 256 + wc * 32 + 8 * fq, b = u.pm >> 3;
        const float* gp = mod + (size_t)b * MODW + goff + col0;
        f32x4 gv[2][2];
#pragma unroll
        for (int bj = 0; bj < 2; ++bj)
#pragma unroll
            for (int n = 0; n < 2; ++n) gv[bj][n] = *(const f32x4*)(gp + bj * 128 + 4 * n);
#pragma unroll
        for (int ai = 0; ai < 2; ++ai) {
            f32x4 bv[4][2][2];
#pragma unroll
            for (int m = 0; m < 4; ++m)
#pragma unroll
                for (int bj = 0; bj < 2; ++bj)
#pragma unroll
                    for (int n = 0; n < 2; ++n) bv[m][bj][n] = *(const f32x4*)(base + (size_t)(row0 + ai * 128 + m * 16) * DM + col0 + bj * 128 + 4 * n);
#pragma unroll
            for (int m = 0; m < 4; ++m)
#pragma unroll
                for (int bj = 0; bj < 2; ++bj)
#pragma unroll
                    for (int n = 0; n < 2; ++n) *(f32x4*)(out + (size_t)(row0 + ai * 128 + m * 16) * DM + col0 + bj * 128 + 4 * n) = bv[m][bj][n] + gv[bj][n] * acc[ai][bj][m][n];
        }
    }
};
struct EpiSwiglu {
    static constexpr bool PERM = true, AFTER_DRAIN = false;
    bf16* O;
    __device__ __forceinline__ void operator()(const f32x4 (&acc)[2][2][4][2], const Unit& u, int wr, int wc, int fr, int fq) const {
        const int row0 = u.pm * 256 + wr * 64 + fr, col0 = u.pn * 128 + wc * 32 + 8 * fq;
#pragma unroll
        for (int ai = 0; ai < 2; ++ai)
#pragma unroll
            for (int m = 0; m < 4; ++m) { float o[8];
#pragma unroll
                for (int e = 0; e < 8; ++e) o[e] = silu_(acc[ai][0][m][e >> 2][e & 3]) * acc[ai][1][m][e >> 2][e & 3];
                *(u32x4*)(O + (size_t)(row0 + ai * 128 + m * 16) * DFF + col0) = pack8(o); }
    }
};

__device__ __forceinline__ void transpose_item(const float* __restrict__ W, int K, int N, bf16* WT, int mode, LAS float* scr, int item, int lane) {
    const int nblk = N / 32, kb = item / nblk, nb = item % nblk, k0 = 64 * kb, n0 = 32 * nb;
    float tv[32];
#pragma unroll
    for (int i = 0; i < 32; ++i) tv[i] = W[(size_t)(k0 + 2 * i + (lane >> 5)) * N + n0 + (lane & 31)];
#pragma unroll
    for (int i = 0; i < 32; ++i) scr[(2 * i + (lane >> 5)) * 33 + (lane & 31)] = tv[i];
    LDS_WAIT(); asm volatile("" ::: "memory");
    const int c = lane & 7;
    const int drow0 = (mode == 0) ? n0 : (256 * (n0 >> 7) + (n0 & 127) + (mode == 2 ? 128 : 0));
#pragma unroll
    for (int j = 0; j < 4; ++j) { const int n = (lane >> 3) + 8 * j; const LAS float* s = scr + (8 * c) * 33 + n;
        u32x4 o; o.x = pk2(s[0 * 33], s[1 * 33]); o.y = pk2(s[2 * 33], s[3 * 33]); o.z = pk2(s[4 * 33], s[5 * 33]); o.w = pk2(s[6 * 33], s[7 * 33]);
        *(u32x4*)(WT + (size_t)(drow0 + n) * K + k0 + 8 * c) = o; }
    LDS_WAIT(); asm volatile("" ::: "memory");
}
__device__ __forceinline__ void wcomb_item(const float* __restrict__ w_pool, const float* __restrict__ pscale, const float* __restrict__ w_pa, bf16* WcT, int item, int lane) {
    const int g = item >> 7, rem = item & 127, n = (rem >> 3) * 64 + lane, c0 = (rem & 7) * 16;
    float wcol[128];
#pragma unroll
    for (int d = 0; d < 128; ++d) wcol[d] = w_pa[(size_t)(g * 128 + d) * DM + n];
#pragma unroll
    for (int d = 0; d < 128; ++d) wcol[d] *= pscale[g * 128 + d];
    float res[16];
#pragma unroll 2
    for (int cc = 0; cc < 16; ++cc) { const float* wr = w_pool + (size_t)(g * 128 + c0 + cc) * 128; float a0 = 0.f, a1 = 0.f;
#pragma unroll
        for (int d = 0; d < 128; d += 2) { a0 += wr[d] * wcol[d]; a1 += wr[d + 1] * wcol[d + 1]; }
        res[cc] = a0 + a1; }
    u32x4 o0, o1; o0.x = pk2(res[0], res[1]); o0.y = pk2(res[2], res[3]); o0.z = pk2(res[4], res[5]); o0.w = pk2(res[6], res[7]);
    o1.x = pk2(res[8], res[9]); o1.y = pk2(res[10], res[11]); o1.z = pk2(res[12], res[13]); o1.w = pk2(res[14], res[15]);
    bf16* op = WcT + (size_t)n * PWD + g * 128 + c0; *(u32x4*)op = o0; *(u32x4*)(op + 8) = o1;
}
__device__ __forceinline__ void ada_item(const float* __restrict__ cnd, const float* __restrict__ cctx, const float* __restrict__ w_ada, float* MODP, int item, int lane) {
    const int cb = item % 96, kc = item / 96, col = cb * 64 + lane, kb = kc * 64;
    float wv[64];
    const float* wp = w_ada + (size_t)kb * MODW + col;
#pragma unroll
    for (int kk = 0; kk < 64; ++kk) wv[kk] = wp[(size_t)kk * MODW];
    float sv[9], acc[9];
#pragma unroll
    for (int b = 0; b < 9; ++b) { const float x = (b < 8) ? cnd[b * DM + kb + lane] : cctx[kb + lane]; sv[b] = x / (1.f + expf(-x)); acc[b] = 0.f; }
#pragma unroll
    for (int kk = 0; kk < 64; ++kk) {
#pragma unroll
        for (int b = 0; b < 9; ++b) acc[b] += __int_as_float(__builtin_amdgcn_readlane(__float_as_int(sv[b]), kk)) * wv[kk]; }
#pragma unroll
    for (int b = 0; b < 9; ++b) MODP[((size_t)kc * 9 + b) * MODW + col] = acc[b];
}

template <int U> __device__ __forceinline__ void norm_rows_bf16(const float* src0, bf16* dst0, int r, int rend, int rstride, const f32x4 (&gs)[4], const f32x4 (&sh)[4], int lane) {
    for (; r < rend; r += U * rstride) {
        f32x4 v[U][4];
#pragma unroll
        for (int u = 0; u < U; ++u) if (r + u * rstride < rend) {
#pragma unroll
            for (int j = 0; j < 4; ++j) v[u][j] = *(const f32x4*)(src0 + (size_t)(r + u * rstride) * DM + 4 * lane + 256 * j); }
#pragma unroll
        for (int u = 0; u < U; ++u) if (r + u * rstride < rend) {
            float ss = 0.f;
#pragma unroll
            for (int j = 0; j < 4; ++j) ss += (v[u][j].x * v[u][j].x + v[u][j].y * v[u][j].y) + (v[u][j].z * v[u][j].z + v[u][j].w * v[u][j].w);
            const float rstd = rsqrtf(wave_sum(ss) * (1.f / DM) + EPS);
            bf16* dst = dst0 + (size_t)(r + u * rstride) * DM;
#pragma unroll
            for (int j = 0; j < 4; ++j) { const f32x4 o = v[u][j] * rstd * gs[j] + sh[j]; u32x2 w; w.x = pk2(o.x, o.y); w.y = pk2(o.z, o.w); *(u32x2*)(dst + 4 * lane + 256 * j) = w; } }
    }
}
__device__ __forceinline__ void p1_norm(LAS unsigned char* lds, const float* __restrict__ x, const float* __restrict__ ctx, const float* __restrict__ gain, const float* __restrict__ b_ada, const float* MODP,
                                         bf16* H, bf16* HC, int bx, int G, int tid, int wave, int lane) {
    LAS float* tab = (LAS float*)lds;
    const int total = MT + MCX, per = (total + G - 1) / G, r1 = ((bx + 1) * per < total) ? (bx + 1) * per : total;
    int r = bx * per;
    while (r < r1) {
        const int b = (r < MT) ? (r >> 11) : 8, bend = (b < 8) ? (b + 1) * SL : total, rend = (r1 < bend) ? r1 : bend;
        {   const int col = 2 * tid; f32x2_t s = *(const f32x2_t*)(b_ada + col), c = *(const f32x2_t*)(b_ada + DM + col);
#pragma unroll
            for (int kc = 0; kc < NKC; ++kc) { s += *(const f32x2_t*)(MODP + ((size_t)kc * 9 + b) * MODW + col); c += *(const f32x2_t*)(MODP + ((size_t)kc * 9 + b) * MODW + DM + col); }
            const f32x2_t g = *(const f32x2_t*)(gain + col);
            tab[col] = g.x * (1.f + c.x); tab[col + 1] = g.y * (1.f + c.y); tab[DM + col] = s.x; tab[DM + col + 1] = s.y; }
        __syncthreads();
        f32x4 gs[4], sh[4];
#pragma unroll
        for (int j = 0; j < 4; ++j) { gs[j] = *(const LAS f32x4*)(tab + 4 * lane + 256 * j); sh[j] = *(const LAS f32x4*)(tab + DM + 4 * lane + 256 * j); }
        if (b < 8) norm_rows_bf16<3>(x, H, r + wave, rend, NWAVES, gs, sh, lane);
        else norm_rows_bf16<3>(ctx - (size_t)MT * DM, HC - (size_t)MT * DM, r + wave, rend, NWAVES, gs, sh, lane);
        __syncthreads();
        r = rend;
    }
}
__device__ __forceinline__ void p8_norm(const float* x1, const float* __restrict__ gain, const float* MOD, bf16* H2, int bx, int G, int wave, int lane) {
    const int per = (MT + G - 1) / G, r1 = ((bx + 1) * per < MT) ? (bx + 1) * per : MT;
    int r = bx * per;
    while (r < r1) {
        const int b = r >> 11, bend = (b + 1) * SL, rend = (r1 < bend) ? r1 : bend;
        f32x4 gs[4], sh[4];
#pragma unroll
        for (int j = 0; j < 4; ++j) { const int col = 4 * lane + 256 * j;
            const f32x4 s = *(const f32x4*)(MOD + (size_t)b * MODW + 3 * DM + col), c = *(const f32x4*)(MOD + (size_t)b * MODW + 4 * DM + col), g = *(const f32x4*)(gain + col);
            sh[j] = s; gs[j] = g * (c + 1.0f); }
        norm_rows_bf16<4>(x1, H2, r + wave, rend, NWAVES, gs, sh, lane);
        r = rend;
    }
}
__device__ __forceinline__ void p11_norm(float* out, const float* __restrict__ gain, int gw, int NGW, int lane) {
    f32x4 g[4];
#pragma unroll
    for (int j = 0; j < 4; ++j) g[j] = *(const f32x4*)(gain + 4 * lane + 256 * j);
    constexpr int U = 4;
    for (int r = gw; r < MT; r += U * NGW) {
        f32x4 v[U][4];
#pragma unroll
        for (int u = 0; u < U; ++u) if (r + u * NGW < MT) {
#pragma unroll
            for (int j = 0; j < 4; ++j) v[u][j] = *(const f32x4*)(out + (size_t)(r + u * NGW) * DM + 4 * lane + 256 * j); }
#pragma unroll
        for (int u = 0; u < U; ++u) if (r + u * NGW < MT) {
            float ss = 0.f;
#pragma unroll
            for (int j = 0; j < 4; ++j) ss += (v[u][j].x * v[u][j].x + v[u][j].y * v[u][j].y) + (v[u][j].z * v[u][j].z + v[u][j].w * v[u][j].w);
            const float rstd = rsqrtf(wave_sum(ss) * (1.f / DM) + EPS);
            float* p = out + (size_t)(r + u * NGW) * DM;
#pragma unroll
            for (int j = 0; j < 4; ++j) *(f32x4*)(p + 4 * lane + 256 * j) = v[u][j] * rstd * g[j]; }
    }
}

__device__ __forceinline__ int vt_off(int v, int j) { return v * 272 + ((((j >> 3) ^ (v >> 3)) & 15) << 4) + (j & 7) * 2; }
__device__ __forceinline__ void stage_vt(LAS unsigned char* vt, const bf16* vbase, int ld, int tid) {
    const int vseg = tid & 15, j0 = (tid >> 4) * 4;
    u32x4 r[4];
#pragma unroll
    for (int jj = 0; jj < 4; ++jj) r[jj] = *(const u32x4*)(vbase + (size_t)(j0 + jj) * ld + vseg * 8);
#pragma unroll
    for (int e2 = 0; e2 < 4; ++e2) {
        const unsigned a0 = r[0][e2], a1 = r[1][e2], a2 = r[2][e2], a3 = r[3][e2];
        u32x2 lo, hi; lo.x = (a0 & 0xffffu) | (a1 << 16); lo.y = (a2 & 0xffffu) | (a3 << 16); hi.x = (a0 >> 16) | (a1 & 0xffff0000u); hi.y = (a2 >> 16) | (a3 & 0xffff0000u);
        const int v = vseg * 8 + 2 * e2;
        *(LAS u32x2*)(vt + vt_off(v, j0)) = lo; *(LAS u32x2*)(vt + vt_off(v + 1, j0)) = hi;
    }
}
__device__ __forceinline__ void rope_cs(int tok, int f, float& cs, float& sn) {
    const float pos = (float)((f < 16) ? (tok >> 6) : (tok & 63));
    const float ang = pos * ex2(-(float)(f & 15) * 0.8304820237218406f);
    cs = __cosf(ang); sn = __sinf(ang);
}
__device__ __forceinline__ void a_item(LAS unsigned char* lds, const bf16* Z, const bf16* ZC, bf16* AT, float lgf2, float lgb2, int b, int h, int pos, int tid, int wave, int lane) {
    LAS unsigned char* Vt = lds; LAS unsigned char* Kt = lds + 34816;
    const bool lat = pos >= 2; const int c = pos - 2;
    const bf16* kbase = lat ? Z + ((size_t)b * SL + c * 128) * INW + K_OFF + h * DK : ZC + ((size_t)b * LCX + pos * 128) * 1536 + h * DK;
    const bf16* vbase = lat ? Z + ((size_t)b * SL + c * 128) * INW + V_OFF + h * DV : ZC + ((size_t)b * LCX + pos * 128) * 1536 + 512 + h * DV;
    const int ld = lat ? INW : 1536;
    stage_vt(Vt, vbase, ld, tid);
    if (tid < 256) {
        const int tt = tid & 127, dir = tid >> 7, ds = tt & 3, j0 = (tt >> 2) * 4, d0 = ds * 8;
        const float lg2 = dir ? lgb2 : lgf2;
        unsigned p1[8][2], p2[8][2];
#pragma unroll
        for (int jp = 0; jp < 2; ++jp) {
            float o1[2][8], o2[2][8];
#pragma unroll
            for (int q = 0; q < 2; ++q) { const int j = j0 + 2 * jp + q;
                float x1[8], x2[8]; unpack8(*(const u32x4*)(kbase + (size_t)j * ld + d0), x1); unpack8(*(const u32x4*)(kbase + (size_t)j * ld + 32 + d0), x2);
                const float dec = ex2(lg2 * (float)(dir ? j : 127 - j)) * 0.125f;
#pragma unroll
                for (int e = 0; e < 8; ++e) {
                    float a = x1[e], bb = x2[e];
                    if (lat) { float cs, sn; rope_cs(c * 128 + j, d0 + e, cs, sn); const float t1 = a * cs - bb * sn, t2 = a * sn + bb * cs; a = t1; bb = t2; }
                    o1[q][e] = a * dec; o2[q][e] = bb * dec; } }
#pragma unroll
            for (int e = 0; e < 8; ++e) { p1[e][jp] = pk2(o1[0][e], o1[1][e]); p2[e][jp] = pk2(o2[0][e], o2[1][e]); }
        }
#pragma unroll
        for (int e = 0; e < 8; ++e) { u32x2 w1, w2; w1.x = p1[e][0]; w1.y = p1[e][1]; w2.x = p2[e][0]; w2.y = p2[e][1];
            *(LAS u32x2*)(Kt + vt_off(dir * 64 + d0 + e, j0)) = w1; *(LAS u32x2*)(Kt + vt_off(dir * 64 + 32 + d0 + e, j0)) = w2; }
    }
    __syncthreads();
    const int fr = lane & 15, fq = lane >> 4;
    f32x4 acc[8];
#pragma unroll
    for (int ct = 0; ct < 8; ++ct) acc[ct] = (f32x4){0.f, 0.f, 0.f, 0.f};
#pragma unroll
    for (int ks = 0; ks < 4; ++ks) {
        const bf16x8 a = *(const LAS bf16x8*)(Vt + vt_off(16 * wave + fr, 32 * ks + 8 * fq));
#pragma unroll
        for (int ct = 0; ct < 8; ++ct) { const bf16x8 bb = *(const LAS bf16x8*)(Kt + vt_off(16 * ct + fr, 32 * ks + 8 * fq)); acc[ct] = __builtin_amdgcn_mfma_f32_16x16x32_bf16(a, bb, acc[ct], 0, 0, 0); }
    }
    bf16* ob = AT + ((size_t)((b * NH + h) * NPOS + pos)) * 16384;
#pragma unroll
    for (int ct = 0; ct < 8; ++ct)
#pragma unroll
        for (int r = 0; r < 4; ++r) ob[(16 * wave + 4 * fq + r) * 128 + 16 * ct + fr] = f2bf(acc[ct][r]);
    __syncthreads();
}
__device__ __forceinline__ void pool_item(LAS unsigned char* lds, const bf16* Z, bf16* Db, int b, int g, int r, int chh, int tid) {
    LAS float* cs = (LAS float*)lds;
    const int c = tid >> 3, sg = tid & 7, ch0 = g * 128 + chh * 64 + sg * 8, hw = 1 << g;
    const int rlo = (r - hw > 0) ? r - hw : 0, rhi = (r + hw < 32) ? r + hw : 32, clo = (c - hw > 0) ? c - hw : 0, chi = (c + hw < 64) ? c + hw : 64;
    float sum[8], own[8];
#pragma unroll
    for (int e = 0; e < 8; ++e) { sum[e] = 0.f; own[e] = 0.f; }
    for (int rr = rlo; rr < rhi; ++rr) {
        float x[8]; unpack8(*(const u32x4*)(Z + ((size_t)b * SL + rr * 64 + c) * INW + ch0), x);
#pragma unroll
        for (int e = 0; e < 8; ++e) { sum[e] += x[e]; if (rr == r) own[e] = x[e]; }
    }
    *(LAS f32x4*)(cs + c * 68 + sg * 8) = (f32x4){sum[0], sum[1], sum[2], sum[3]}; *(LAS f32x4*)(cs + c * 68 + sg * 8 + 4) = (f32x4){sum[4], sum[5], sum[6], sum[7]};
    __syncthreads();
    f32x4 h0 = (f32x4){0.f, 0.f, 0.f, 0.f}, h1 = h0;
    for (int cc = clo; cc < chi; ++cc) { h0 += *(const LAS f32x4*)(cs + cc * 68 + sg * 8); h1 += *(const LAS f32x4*)(cs + cc * 68 + sg * 8 + 4); }
    const float inv = 1.f / (float)((rhi - rlo) * (chi - clo));
    float o[8];
#pragma unroll
    for (int e = 0; e < 4; ++e) { o[e] = h0[e] * inv - own[e]; o[4 + e] = h1[e] * inv - own[4 + e]; }
    *(u32x4*)(Db + ((size_t)b * SL + r * 64 + c) * PWD + ch0) = pack8(o);
    __syncthreads();
}
__device__ __forceinline__ void scan_item(const bf16* AT, bf16* ST, float lgf2, float lgb2, int bh, int q, int tid) {
    const int e0 = q * 4096 + tid * 8; const bool dirb = ((tid & 15) >= 8);
    const float cd = ex2((dirb ? lgb2 : lgf2) * 128.f);
    const bf16* ab = AT + (size_t)bh * NPOS * 16384 + e0; bf16* sb = ST + (size_t)bh * NCH * 16384 + e0;
    float S[8];
#pragma unroll
    for (int e = 0; e < 8; ++e) S[e] = 0.f;
#pragma unroll
    for (int s = 0; s < NPOS; ++s) {
        if (s >= 2) { const int cc = dirb ? 17 - s : s - 2; *(u32x4*)(sb + (size_t)cc * 16384) = pack8(S); }
        if (s < NPOS - 1) { const int posr = dirb ? (s < 2 ? 1 - s : 19 - s) : s; float a[8]; unpack8(*(const u32x4*)(ab + (size_t)posr * 16384), a);
#pragma unroll
            for (int e = 0; e < 8; ++e) S[e] = cd * S[e] + a[e]; }
    }
}
#define WG_BARRIER() do { asm volatile("s_waitcnt lgkmcnt(0)" ::: "memory"); __builtin_amdgcn_s_barrier(); asm volatile("" ::: "memory"); } while (0)
struct R3Pre { u32x4 q1, q2, k1, k2, v[4]; };
__device__ __forceinline__ void r3_load(R3Pre& p, const bf16* Z, const bf16* ST, int it, int tid, int wave, int lane) {
    const int bh = it >> 4, c = it & 15, b = bh >> 3, h = bh & 7; const size_t grow0 = (size_t)b * SL + c * 128;
    {   const bf16* zr = Z + (grow0 + (tid >> 2)) * INW + h * DK + (tid & 3) * 8;
        p.q1 = *(const u32x4*)(zr + Q_OFF); p.q2 = *(const u32x4*)(zr + Q_OFF + 32); p.k1 = *(const u32x4*)(zr + K_OFF); p.k2 = *(const u32x4*)(zr + K_OFF + 32); }
    {   const bf16* vb = Z + (grow0 + (tid >> 4) * 4) * INW + V_OFF + h * DV + (tid & 15) * 8;
#pragma unroll
        for (int jj = 0; jj < 4; ++jj) p.v[jj] = *(const u32x4*)(vb + (size_t)jj * INW); }
}
__device__ __forceinline__ void vt_write(LAS unsigned char* vt, const u32x4 (&r)[4], int tid) {
    const int vseg = tid & 15, j0 = (tid >> 4) * 4;
#pragma unroll
    for (int e2 = 0; e2 < 4; ++e2) {
        const unsigned a0 = r[0][e2], a1 = r[1][e2], a2 = r[2][e2], a3 = r[3][e2];
        u32x2 lo, hi; lo.x = (a0 & 0xffffu) | (a1 << 16); lo.y = (a2 & 0xffffu) | (a3 << 16); hi.x = (a0 >> 16) | (a1 & 0xffff0000u); hi.y = (a2 >> 16) | (a3 & 0xffff0000u);
        const int v = vseg * 8 + 2 * e2;
        *(LAS u32x2*)(vt + vt_off(v, j0)) = lo; *(LAS u32x2*)(vt + vt_off(v + 1, j0)) = hi;
    }
}
__device__ __forceinline__ void r3_item(LAS unsigned char* lds, R3Pre& pre, const bf16* Z, const bf16* ST, bf16* YN, const float* __restrict__ gnw, const float* __restrict__ dec_f, const float* __restrict__ dec_b,
                                         int it, int nxt, int tid, int wave, int lane) {
    asm volatile("" : "+v"(tid), "+v"(lane));
    LAS unsigned char* Qs = lds; LAS unsigned char* Ks = lds + 18432; LAS unsigned char* Vt = lds + 36864; LAS unsigned char* Ps = lds + 71680; LAS unsigned char* Ss = lds + 106496;
    const int bh = it >> 4, c = it & 15, b = bh >> 3, h = bh & 7;
    const float lgf2 = log2_sigmoid(dec_f[h]), lgb2 = log2_sigmoid(dec_b[h]);
    const size_t grow0 = (size_t)b * SL + c * 128;
    u32x4 stv[4], gcur[4];
    {   const bf16* sp = ST + ((size_t)(bh * NCH + c)) * 16384;
#pragma unroll
        for (int i = 0; i < 4; ++i) { const int idx = tid + NTHR * i; stv[i] = *(const u32x4*)(sp + (idx >> 4) * 128 + (idx & 15) * 8); } }
#pragma unroll
    for (int i = 0; i < 4; ++i) { const int idx = lane + 64 * i; gcur[i] = *(const u32x4*)(Z + (grow0 + 16 * wave + (idx >> 4)) * INW + G_OFF + h * DV + (idx & 15) * 8); }
    {
        const int row = tid >> 2, d0 = (tid & 3) * 8, tok = c * 128 + row;
        float q1[8], q2[8], k1[8], k2[8];
        unpack8(pre.q1, q1); unpack8(pre.q2, q2); unpack8(pre.k1, k1); unpack8(pre.k2, k2);
        float qa[8], qb[8], ka[8], kb[8];
#pragma unroll
        for (int e = 0; e < 8; ++e) { float cs, sn; rope_cs(tok, d0 + e, cs, sn);
            qa[e] = q1[e] * cs - q2[e] * sn; qb[e] = q1[e] * sn + q2[e] * cs;
            ka[e] = (k1[e] * cs - k2[e] * sn) * 0.125f; kb[e] = (k1[e] * sn + k2[e] * cs) * 0.125f; }
        *(LAS u32x4*)(Qs + row * 144 + d0 * 2) = pack8(qa); *(LAS u32x4*)(Qs + row * 144 + (32 + d0) * 2) = pack8(qb);
        *(LAS u32x4*)(Ks + row * 144 + d0 * 2) = pack8(ka); *(LAS u32x4*)(Ks + row * 144 + (32 + d0) * 2) = pack8(kb);
    }
    vt_write(Vt, pre.v, tid);
#pragma unroll
    for (int i = 0; i < 4; ++i) { const int idx = tid + NTHR * i; *(LAS u32x4*)(Ss + (idx >> 4) * 272 + (idx & 15) * 16) = stv[i]; }
    if (nxt >= 0) r3_load(pre, Z, ST, nxt, tid, wave, lane);
    WG_BARRIER();
    const int fr = lane & 15, fq = lane >> 4, i0 = 16 * wave;
    f32x4 s[8];
#pragma unroll
    for (int ct = 0; ct < 8; ++ct) s[ct] = (f32x4){0.f, 0.f, 0.f, 0.f};
#pragma unroll
    for (int ks = 0; ks < 2; ++ks) {
        const bf16x8 a = *(const LAS bf16x8*)(Qs + (i0 + fr) * 144 + (32 * ks + 8 * fq) * 2);
#pragma unroll
        for (int ct = 0; ct < 8; ++ct) { const bf16x8 bb = *(const LAS bf16x8*)(Ks + (16 * ct + fr) * 144 + (32 * ks + 8 * fq) * 2); s[ct] = __builtin_amdgcn_mfma_f32_16x16x32_bf16(a, bb, s[ct], 0, 0, 0); }
    }
#pragma unroll
    for (int ct = 0; ct < 8; ++ct)
#pragma unroll
        for (int r = 0; r < 4; ++r) { const int i = i0 + 4 * fq + r, j = 16 * ct + fr, df = i - j;
            const float dv = ex2(df >= 0 ? lgf2 * (float)df : lgb2 * (float)(-df));
            *(LAS bf16*)(Ps + i * 272 + j * 2) = f2bf(s[ct][r] * dv); }
    asm volatile("s_waitcnt lgkmcnt(0)" ::: "memory");
    f32x4 o[8];
#pragma unroll
    for (int vt = 0; vt < 8; ++vt) o[vt] = (f32x4){0.f, 0.f, 0.f, 0.f};
#pragma unroll
    for (int ks = 0; ks < 4; ++ks) {
        const bf16x8 a = *(const LAS bf16x8*)(Ps + (i0 + fr) * 272 + (32 * ks + 8 * fq) * 2);
#pragma unroll
        for (int vt = 0; vt < 8; ++vt) { const bf16x8 bb = *(const LAS bf16x8*)(Vt + vt_off(16 * vt + fr, 32 * ks + 8 * fq)); o[vt] = __builtin_amdgcn_mfma_f32_16x16x32_bf16(a, bb, o[vt], 0, 0, 0); }
    }
    {   const int il = i0 + fr; const float dff = ex2(lgf2 * (float)(il + 1)), dbb = ex2(lgb2 * (float)(128 - il));
#pragma unroll
        for (int ks = 0; ks < 4; ++ks) {
            float qv[8]; unpack8(*(const LAS u32x4*)(Qs + il * 144 + (32 * (ks & 1) + 8 * fq) * 2), qv);
            const float dec = (ks < 2) ? dff : dbb;
#pragma unroll
            for (int e = 0; e < 8; ++e) qv[e] *= dec;
            const u32x4 pa = pack8(qv); const bf16x8 a = __builtin_bit_cast(bf16x8, pa);
#pragma unroll
            for (int vt = 0; vt < 8; ++vt) { const bf16x8 bb = *(const LAS bf16x8*)(Ss + (16 * vt + fr) * 272 + (32 * ks + 8 * fq) * 2); o[vt] = __builtin_amdgcn_mfma_f32_16x16x32_bf16(a, bb, o[vt], 0, 0, 0); }
        }
    }
    float gw_[8];
#pragma unroll
    for (int vt = 0; vt < 8; ++vt) gw_[vt] = gnw[h * DV + 16 * vt + fr];
#pragma unroll
    for (int r = 0; r < 4; ++r) {
        float sm = 0.f;
#pragma unroll
        for (int vt = 0; vt < 8; ++vt) sm += o[vt][r];
        sm += __shfl_xor(sm, 1); sm += __shfl_xor(sm, 2); sm += __shfl_xor(sm, 4); sm += __shfl_xor(sm, 8);
        const float mu = sm * (1.f / DV); float vs = 0.f;
#pragma unroll
        for (int vt = 0; vt < 8; ++vt) { const float d = o[vt][r] - mu; vs += d * d; }
        vs += __shfl_xor(vs, 1); vs += __shfl_xor(vs, 2); vs += __shfl_xor(vs, 4); vs += __shfl_xor(vs, 8);
        const float rstd = rsqrtf(vs * (1.f / DV) + EPS);
#pragma unroll
        for (int vt = 0; vt < 8; ++vt) *(LAS bf16*)(Ps + (i0 + 4 * fq + r) * 272 + (16 * vt + fr) * 2) = f2bf((o[vt][r] - mu) * rstd * gw_[vt]);
    }
    asm volatile("s_waitcnt lgkmcnt(0)" ::: "memory");
#pragma unroll
    for (int i = 0; i < 4; ++i) { const int idx = lane + 64 * i, row = i0 + (idx >> 4), seg = idx & 15;
        float y[8], g[8]; unpack8(*(const LAS u32x4*)(Ps + row * 272 + seg * 16), y); unpack8(gcur[i], g);
#pragma unroll
        for (int e = 0; e < 8; ++e) y[e] *= silu_(g[e]);
        *(u32x4*)(YN + (grow0 + row) * DM + h * DV + seg * 8) = pack8(y); }
    WG_BARRIER();
}
#define XB_TMO      128
#define XB_XCNT(j)  (256  + 64 * (j))
#define XB_XSUB(j)  (1280 + 64 * (j))
#define XB_XGEN(j)  (2304 + 64 * (j))
#define XB_TOP      3328
#define XB_TOPGEN   3392
#define XCD_BAR_WORDS 3456
#define XB_SPIN_CAP (1u << 18)

__device__ __forceinline__ unsigned xb_ld(unsigned* p)              { return __hip_atomic_load(p, __ATOMIC_RELAXED, __HIP_MEMORY_SCOPE_AGENT); }
__device__ __forceinline__ unsigned xb_add(unsigned* p, unsigned v) { return __hip_atomic_fetch_add(p, v, __ATOMIC_RELAXED, __HIP_MEMORY_SCOPE_AGENT); }
__device__ __forceinline__ unsigned xb_xcc_id() { return (unsigned)__builtin_amdgcn_s_getreg((3 << 11) | 20) & 0xFu; }
#define XB_SPIN(cond, bar) do { unsigned _sp = 0; while (cond) { __builtin_amdgcn_s_sleep(1); \
    if ((++_sp & 255u) == 0u) { if (xb_ld(&(bar)[XB_TMO])) break; if (_sp > XB_SPIN_CAP) { atomicAdd(&(bar)[XB_TMO], 1u); break; } } } } while (0)

struct XcdBarrier {
    unsigned* bar; unsigned x;
    volatile LAS unsigned* st;
};

__device__ __forceinline__ XcdBarrier xcd_barrier_post(unsigned* bar, volatile LAS unsigned* st) {
    XcdBarrier b; b.bar = bar; b.x = xb_xcc_id(); b.st = st;
    if (threadIdx.x == 0) (void)xb_add(&bar[XB_XCNT(b.x)], 1u);
    return b;
}
__device__ __forceinline__ void xcd_barrier_complete(unsigned* bar, unsigned x, unsigned& nloc, unsigned& nx) {
    const unsigned G = gridDim.x * gridDim.y * gridDim.z;
    unsigned sum, cnt, mine, sp = 0u;
    for (;;) {
        sum = 0u; cnt = 0u; mine = 0u;
#pragma unroll
        for (unsigned j = 0; j < 16; ++j) { const unsigned c = xb_ld(&bar[XB_XCNT(j)]); sum += c; cnt += (c > 0u) ? 1u : 0u; mine = (j == x) ? c : mine; }
        if (sum == G) break;
        __builtin_amdgcn_s_sleep(1);
        if ((++sp & 255u) == 0u) { if (xb_ld(&bar[XB_TMO])) break; if (sp > XB_SPIN_CAP) { atomicAdd(&bar[XB_TMO], 1u); break; } }
    }
    nloc = mine > 0u ? mine : 1u; nx = cnt > 0u ? cnt : 1u;
}

__device__ __forceinline__ void xcd_barrier(const XcdBarrier& b) {
    asm volatile("s_waitcnt vmcnt(0)" ::: "memory");
    __syncthreads();
    if (threadIdx.x == 0) {
        unsigned* bar = b.bar;
        __builtin_amdgcn_s_waitcnt(0);
        unsigned nloc = b.st[0], nx = b.st[1];
        if (nloc == 0u) { xcd_barrier_complete(bar, b.x, nloc, nx); b.st[0] = nloc; b.st[1] = nx; }
        const unsigned old = xb_add(&bar[XB_XSUB(b.x)], 1u);
        const unsigned gen = old / nloc;
        if (old + 1u == (gen + 1u) * nloc) {
            __builtin_amdgcn_fence(__ATOMIC_RELEASE, "agent");
            asm volatile("s_waitcnt vmcnt(0)" ::: "memory");
            const unsigned og = xb_add(&bar[XB_TOP], 1u);
            const unsigned tg = og / nx;
            if (og + 1u == (tg + 1u) * nx) xb_add(&bar[XB_TOPGEN], 1u);
            else XB_SPIN(xb_ld(&bar[XB_TOPGEN]) == tg, bar);
            __builtin_amdgcn_fence(__ATOMIC_ACQUIRE, "agent");
            xb_add(&bar[XB_XGEN(b.x)], 1u);
            asm volatile("s_waitcnt vmcnt(0)" ::: "memory");
        } else {
            XB_SPIN(xb_ld(&bar[XB_XGEN(b.x)]) == gen, bar);
            __builtin_amdgcn_fence(__ATOMIC_ACQUIRE, "agent");
            asm volatile("s_waitcnt vmcnt(0)" ::: "memory");
        }
    }
    __syncthreads();
}

struct Args { const float* in[21]; float* out; unsigned char* ws; int ph_lo, ph_hi; };
__global__ void __launch_bounds__(NTHR) mk_fwd(Args args) {
    extern __shared__ __attribute__((aligned(16))) unsigned char lds_raw[];
    LAS unsigned char* lds = (LAS unsigned char*)lds_raw;
    cg::grid_group grid = cg::this_grid();
    const int tid = threadIdx.x, lane = tid & 63, wave = __builtin_amdgcn_readfirstlane(tid >> 6);
    const int G = gridDim.x, bx = blockIdx.x, gw = bx * NWAVES + wave, NGW = G * NWAVES;
    const float* x = args.in[0]; const float* cnd = args.in[1]; const float* ctx = args.in[2]; const float* cctx = args.in[3];
    const float* w_ada = args.in[4]; const float* b_ada = args.in[5]; const float* norm_mix = args.in[6]; const float* norm_ffn = args.in[7];
    const float* w_in = args.in[8]; const float* w_pool = args.in[9]; const float* pscale = args.in[10]; const float* dec_f = args.in[11]; const float* dec_b = args.in[12];
    const float* gn_w = args.in[13]; const float* w_pa = args.in[14]; const float* w_rb = args.in[15]; const float* w_o = args.in[16];
    const float* w_ff1 = args.in[17]; const float* w_ff3 = args.in[18]; const float* w_ff2 = args.in[19]; const float* norm_final = args.in[20];
    float* out = args.out; unsigned char* ws = args.ws;
    bf16* W13T = (bf16*)(ws + WS_W13); bf16* W2T = (bf16*)(ws + WS_W2); bf16* WcT = (bf16*)(ws + WS_WCOMB); bf16* WrbT = (bf16*)(ws + WS_WRB); bf16* WoT = (bf16*)(ws + WS_WO);
    float* MODP = (float*)(ws + WS_MODP); float* MOD = (float*)(ws + WS_MOD);
    bf16* Z = (bf16*)(ws + WS_Z); bf16* WinT = (bf16*)(ws + WS_WIN); bf16* H = (bf16*)(ws + WS_H); bf16* HC = (bf16*)(ws + WS_HC); bf16* ZC = (bf16*)(ws + WS_ZC);
    bf16* Db = (bf16*)(ws + WS_D); bf16* ST = (bf16*)(ws + WS_ST); bf16* MG = (bf16*)(ws + WS_MERGED); bf16* H2 = (bf16*)(ws + WS_H2); bf16* HMID = (bf16*)(ws + WS_HMID);
    bf16* AT = (bf16*)out; bf16* YN = (bf16*)out;
    const int lo = args.ph_lo, hi = args.ph_hi;
    const bool one_launch = (hi - lo) > 1;
    volatile LAS unsigned* xst = (volatile LAS unsigned*)(lds + LDS_BYTES - 64);
    unsigned* xbar = (unsigned*)ws;
    if (one_launch) {
        if (tid == 0) { xst[0] = 0u; xst[1] = 0u; }
        if (bx == 0) for (int i = tid; i < XCD_BAR_WORDS; i += NTHR) __hip_atomic_store(xbar + i, 0u, __ATOMIC_RELAXED, __HIP_MEMORY_SCOPE_AGENT);
        __syncthreads();
    }
    XcdBarrier xb; xb.bar = xbar; xb.x = 0; xb.st = xst;
#define IN(k) (lo <= (k) && (k) < hi)
#define SEAM(k) do { if (IN(k) && IN((k) + 1)) { if ((k) == 0) { grid.sync(); xb = xcd_barrier_post(xbar, xst); } else xcd_barrier(xb); } } while (0)

    if (IN(0)) for (int rep_ = 0; rep_ < REPS[0]; ++rep_) {
        LAS float* scr = (LAS float*)(lds + wave * 16384);
        constexpr int I_ADA = 96 * NKC, I_WC = 512, I_IN = (DM / 64) * (INW / 32), I_F1 = (DM / 64) * (DFF / 32), I_F2 = (DFF / 64) * (DM / 32), I_SQ = (DM / 64) * (DM / 32);
        constexpr int NIT = I_ADA + I_WC + I_IN + 2 * I_F1 + I_F2 + 2 * I_SQ;
        for (int it = gw; it < NIT; it += NGW) {
            int r = it;
            if (r < I_ADA) { ada_item(cnd, cctx, w_ada, MODP, r, lane); continue; } r -= I_ADA;
            if (r < I_WC) { wcomb_item(w_pool, pscale, w_pa, WcT, r, lane); continue; } r -= I_WC;
            if (r < I_IN) { transpose_item(w_in, DM, INW, WinT, 0, scr, r, lane); continue; } r -= I_IN;
            if (r < I_F1) { transpose_item(w_ff1, DM, DFF, W13T, 1, scr, r, lane); continue; } r -= I_F1;
            if (r < I_F1) { transpose_item(w_ff3, DM, DFF, W13T, 2, scr, r, lane); continue; } r -= I_F1;
            if (r < I_F2) { transpose_item(w_ff2, DFF, DM, W2T, 0, scr, r, lane); continue; } r -= I_F2;
            if (r < I_SQ) { transpose_item(w_rb, DM, DM, WrbT, 0, scr, r, lane); continue; } r -= I_SQ;
            transpose_item(w_o, DM, DM, WoT, 0, scr, r, lane);
        }
    }
    SEAM(0);
    if (IN(1)) for (int rep_ = 0; rep_ < REPS[1]; ++rep_) {
        p1_norm(lds, x, ctx, norm_mix, b_ada, MODP, H, HC, bx, G, tid, wave, lane);
        for (int i = bx * NTHR + tid; i < 9 * MODW; i += G * NTHR) { float s = b_ada[i % MODW];
#pragma unroll
            for (int kc = 0; kc < NKC; ++kc) s += MODP[(size_t)kc * 9 * MODW + i];
            MOD[i] = s; }
    }
    SEAM(1);
    if (IN(2)) for (int rep_ = 0; rep_ < REPS[2]; ++rep_) {
        pg8::Gemm g{H, WinT, HC, WinT + (size_t)K_OFF * DM, DM}; pg8::StaticOrder S; S.init(MT, INW, G, bx, MCX, 1536);
        EpiZ E{Z, ZC};
        pg8::gemm_phase<EpiZ, pg8::StaticOrder, true, true>(lds, g, S, E);
    }
    SEAM(2);
    if (IN(3)) for (int rep_ = 0; rep_ < REPS[3]; ++rep_) {
        constexpr int N_A = NB * NH * NPOS, N_P = NB * 4 * 32 * 2;
        for (int it = bx; it < N_A + N_P; it += G) {
            if (it < N_A) { const int bh = it / NPOS, pos = it % NPOS, b = bh >> 3, h = bh & 7;
                a_item(lds, Z, ZC, AT, log2_sigmoid(dec_f[h]), log2_sigmoid(dec_b[h]), b, h, pos, tid, wave, lane); }
            else { const int r_ = it - N_A, g = 3 - (r_ >> 9), rem = r_ & 511, b = rem >> 6, rr = (rem >> 1) & 31, chh = rem & 1;
                pool_item(lds, Z, Db, b, g, rr, chh, tid); }
        }
    }
    SEAM(3);
    if (IN(4)) for (int rep_ = 0; rep_ < REPS[4]; ++rep_) {
        for (int it = bx; it < NB * NH * 4; it += G) { const int bh = it >> 2, q = it & 3, h = bh & 7;
            scan_item(AT, ST, log2_sigmoid(dec_f[h]), log2_sigmoid(dec_b[h]), bh, q, tid); }
    }
    SEAM(4);
    if (IN(5)) for (int rep_ = 0; rep_ < REPS[5]; ++rep_) {
        constexpr int N_R = NB * NH * NCH;
        R3Pre pre; int it = bx;
        if (it < N_R) r3_load(pre, Z, ST, it, tid, wave, lane);
        while (it < N_R) { const int nx = it + G; r3_item(lds, pre, Z, ST, YN, gn_w, dec_f, dec_b, it, nx < N_R ? nx : -1, tid, wave, lane); it = nx; }
    }
    SEAM(5);
    if (IN(6)) for (int rep_ = 0; rep_ < REPS[6]; ++rep_) {
        { pg8::Gemm g{Db, WcT, Db, WcT, PWD}; pg8::StaticOrder S; S.init(MT, DM, G, bx); EpiGate<false> E{Z, GA_OFF, MG};
          pg8::gemm_phase<EpiGate<false>, pg8::StaticOrder, true, true>(lds, g, S, E); }
        { pg8::Gemm g{YN, WrbT, YN, WrbT, DM}; pg8::StaticOrder S; S.init(MT, DM, G, bx); EpiGate<true> E{Z, GB_OFF, MG};
          pg8::gemm_phase<EpiGate<true>, pg8::StaticOrder, true, true>(lds, g, S, E); }
    }
    SEAM(6);
    if (IN(7)) for (int rep_ = 0; rep_ < REPS[7]; ++rep_) {
        pg8::Gemm g{MG, WoT, MG, WoT, DM}; pg8::StaticOrder S; S.init(MT, DM, G, bx); EpiRes E{x, out, MOD, 2 * DM};
        pg8::gemm_phase<EpiRes, pg8::StaticOrder, true, true>(lds, g, S, E);
    }
    SEAM(7);
    if (IN(8)) for (int rep_ = 0; rep_ < REPS[8]; ++rep_) p8_norm(out, norm_ffn, MOD, H2, bx, G, wave, lane);
    SEAM(8);
    if (IN(9)) for (int rep_ = 0; rep_ < REPS[9]; ++rep_) {
        pg8::Gemm g{H2, W13T, H2, W13T, DM}; pg8::StaticOrder S; S.init(MT, 2 * DFF, G, bx); EpiSwiglu E{HMID};
        pg8::gemm_phase<EpiSwiglu, pg8::StaticOrder, true, true>(lds, g, S, E);
    }
    SEAM(9);
    if (IN(10)) for (int rep_ = 0; rep_ < REPS[10]; ++rep_) {
        pg8::Gemm g{HMID, W2T, HMID, W2T, DFF}; pg8::StaticOrder S; S.init(MT, DM, G, bx); EpiRes E{out, out, MOD, 5 * DM};
        pg8::gemm_phase<EpiRes, pg8::StaticOrder, true, true>(lds, g, S, E);
    }
    SEAM(10);
    if (IN(11)) p11_norm(out, norm_final, gw, NGW, lane);
#undef IN
#undef SEAM
}

extern "C" void kernel_launch(void* const* d_in, const int* in_sizes, int n_in, void* d_out, int out_size, void* d_ws, size_t ws_size, hipStream_t stream) {
    static int grid = 0;
    if (grid == 0) {
        if (n_in != 21 || out_size != MT * DM || ws_size < WS_END) { fprintf(stderr, "kernel_launch: unexpected problem (n_in %d, out %d, ws %zu)\n", n_in, out_size, ws_size); grid = -1; return; }
        int dev = 0, cus = 0, per_cu = 0;
        (void)hipGetDevice(&dev); (void)hipDeviceGetAttribute(&cus, hipDeviceAttributeMultiprocessorCount, dev);
        if (hipFuncSetAttribute((const void*)mk_fwd, hipFuncAttributeMaxDynamicSharedMemorySize, LDS_BYTES) != hipSuccess) { fprintf(stderr, "kernel_launch: hipFuncSetAttribute failed\n"); grid = -1; return; }
        if (hipOccupancyMaxActiveBlocksPerMultiprocessor(&per_cu, (const void*)mk_fwd, NTHR, LDS_BYTES) != hipSuccess || per_cu < 1) per_cu = 1;
        (void)hipGetLastError();
        if (cus <= 0) cus = 256;
        grid = cus * per_cu;
    }
    if (grid < 0) return;
    Args a{};
    for (int i = 0; i < 21; ++i) a.in[i] = (const float*)d_in[i];
    a.out = (float*)d_out; a.ws = (unsigned char*)d_ws;
#if MK_PER_PHASE
    for (int p = 0; p < NPHASE; ++p) { a.ph_lo = p; a.ph_hi = p + 1; hipLaunchKernelGGL(mk_fwd, dim3(grid), dim3(NTHR), LDS_BYTES, stream, a); }
#else
    a.ph_lo = 0; a.ph_hi = NPHASE;
    void* kargs[] = {(void*)&a};
    hipError_t e = hipLaunchCooperativeKernel((const void*)mk_fwd, dim3(grid), dim3(NTHR), kargs, LDS_BYTES, stream);
    if (e != hipSuccess) fprintf(stderr, "kernel_launch: cooperative launch failed: %s (grid %d)\n", hipGetErrorString(e), grid);
#endif
}
```

```cpp
#include <hip/hip_runtime.h>
#include <hip/hip_cooperative_groups.h>
#include <cstdio>
#include <cstdint>
namespace cg = cooperative_groups;

#ifndef MK_PER_PHASE
#define MK_PER_PHASE 0
#endif

namespace pg8 {
#define PG8_LAS __attribute__((address_space(3)))
typedef unsigned short bf16_t;
typedef short bf16x8 __attribute__((ext_vector_type(8)));
typedef float f32x4 __attribute__((ext_vector_type(4)));
typedef unsigned u32x4 __attribute__((ext_vector_type(4)));
constexpr int BM = 256, BK = 64, HALF = 128, HTB = HALF * BK * 2  , STAGE_BYTES = 8 * HTB, NXCD = 8, WGM = 8;

__host__ __device__ __forceinline__ int lds_byte(int r, int c) { const int st = (r >> 4) * 2 + (c >> 5), rr = r & 15, cc = c & 31, ob = rr * 64 + cc * 2; return st * 1024 + (ob ^ (((ob >> 9) & 1) << 5)); }
__host__ __device__ __forceinline__ void stage_rc(int b, int& R, int& C) { const int st = b / 1024, sb = b % 1024, swz = sb ^ (((sb >> 9) & 1) << 5); R = (st >> 1) * 16 + swz / 64; C = (st & 1) * 32 + (swz % 64) / 2; }
__host__ __device__ __forceinline__ int perm32(int rho) { const int n = rho >> 4, i = rho & 15; return 8 * (i >> 2) + 4 * n + (i & 3); }

struct Unit { int pm, pn, g; };
struct Gemm { const bf16_t* A; const bf16_t* Bt; const bf16_t* A2; const bf16_t* Bt2; int K;
    __device__ __forceinline__ const char* abase(const Unit& u) const { return (const char*)(u.g ? A2 : A) + (size_t)u.pm * (size_t)(2 * HALF) * K * 2; }
    __device__ __forceinline__ const char* bbase(const Unit& u) const { return (const char*)(u.g ? Bt2 : Bt) + (size_t)u.pn * (size_t)(2 * HALF) * K * 2; } };

struct StaticOrder {
    int nM, nN, nwg, G, c;
    int n2M, n2N;
    __host__ __device__ void init(int M, int N, int G_, int c_, int M2 = 0, int N2 = 0) { nM = M / BM; nN = N / BM; nwg = nM * nN; G = G_; c = c_; n2M = M2 / BM; n2N = N2 / BM; }
    __host__ __device__ bool next(int i, Unit& u) const {
        const long L = (long)i * G + c; u.g = 0;
        if (L >= nwg) { const long j = L - nwg; if (j >= (long)n2M * n2N) return false; u.g = 1; u.pm = (int)(j % n2M); u.pn = (int)(j / n2M); return true; }
        int wgid = (int)L; { const int q = nwg / NXCD, r = nwg % NXCD, xcd = wgid % NXCD, off = wgid / NXCD; wgid = (xcd < r ? xcd * (q + 1) : r * (q + 1) + (xcd - r) * q) + off; }
        const int nig = WGM * nN, gid = wgid / nig, fm = gid * WGM, gsz = (nM - fm) < WGM ? (nM - fm) : WGM;
        u.pm = fm + ((wgid % nig) % gsz); u.pn = (wgid % nig) / gsz; return true;
    }
    __device__ __forceinline__ void a_ready(const Unit&) const {}
    __device__ __forceinline__ void done(const Unit&) const {}
};

__device__ __forceinline__ unsigned cvt_pk_bf16(float lo, float hi) { unsigned r; asm volatile("v_cvt_pk_bf16_f32 %0, %1, %2" : "=v"(r) : "v"(lo), "v"(hi)); return r; }


template <class Epi, class Sched, bool ALIGN_EPI = false, bool SP2 = false>
__device__ __forceinline__ void gemm_phase(PG8_LAS unsigned char* lds, const Gemm g, const Sched& S, const Epi& E) {
    const int tid = threadIdx.x, wid = __builtin_amdgcn_readfirstlane(tid >> 6), lane = tid & 63, wr = wid >> 2, wc = wid & 3, fr = lane & 15, fq = lane >> 4;
    const int K = g.K, nt = K / BK;
    unsigned voffA[2], voffB[2];
#pragma unroll
    for (int i = 0; i < 2; ++i) { int R, C; stage_rc(tid * 16 + i * 8192, R, C); const int Rb = Epi::PERM ? ((R & ~31) + perm32(R & 31)) : R;
        voffA[i] = (unsigned)(R * K + C) * 2u; voffB[i] = (unsigned)(Rb * K + C) * 2u; }
    const size_t kstep = (size_t)(BK * 2);
    const size_t hstep = (size_t)HALF * K * 2;
    const unsigned ldsw = (unsigned)wid * 1024u;
    const int aoff = lds_byte(wr * 64 + fr, fq * 8), boff = lds_byte(wc * 32 + fr, fq * 8);
#define PG8_SA(b, h) (((b) * 2 + (h)) * HTB)
#define PG8_SB(b, h) ((4 + (b) * 2 + (h)) * HTB)
#define PG8_STAGE(bufoff, gbase, voff) do { _Pragma("unroll") for (int _i = 0; _i < 2; ++_i) \
        __builtin_amdgcn_global_load_lds((const unsigned*)((const char*)(gbase) + (voff)[_i]), (PG8_LAS unsigned*)(lds + (bufoff) + ldsw + _i * 8192), 16, 0, 0); } while (0)
#define PG8_LDA(dst, b, h) do { _Pragma("unroll") for (int m = 0; m < 4; ++m) _Pragma("unroll") for (int k = 0; k < 2; ++k) dst[m][k] = *(const PG8_LAS bf16x8*)(lds + PG8_SA(b, h) + aoff + m * 2048 + k * 1024); } while (0)
#define PG8_LDB(dst, b, h) do { _Pragma("unroll") for (int n = 0; n < 2; ++n) _Pragma("unroll") for (int k = 0; k < 2; ++k) dst[n][k] = *(const PG8_LAS bf16x8*)(lds + PG8_SB(b, h) + boff + n * 2048 + k * 1024); } while (0)
#define PG8_MMA(ai, bj, At, Bt) do { __builtin_amdgcn_s_setprio(1); _Pragma("unroll") for (int m = 0; m < 4; ++m) _Pragma("unroll") for (int n = 0; n < 2; ++n) _Pragma("unroll") for (int k = 0; k < 2; ++k) \
        acc[ai][bj][m][n] = __builtin_amdgcn_mfma_f32_16x16x32_bf16(Bt[n][k], At[m][k], acc[ai][bj][m][n], 0, 0, 0); __builtin_amdgcn_s_setprio(0); } while (0)
#define PG8_WAIT_V(n) asm volatile("s_waitcnt vmcnt(" #n ")" ::: "memory")
#define PG8_WAIT_L(n) asm volatile("s_waitcnt lgkmcnt(" #n ")" ::: "memory")
#define PG8_BAR __builtin_amdgcn_s_barrier()
#define PG8_SCHED __builtin_amdgcn_sched_barrier(0)
    Unit cur, nxt; int ui = 0;
    if (!S.next(0, cur)) return;
    f32x4 acc[2][2][4][2];
#pragma unroll
    for (int a = 0; a < 2; ++a)
#pragma unroll
        for (int b = 0; b < 2; ++b)
#pragma unroll
            for (int m = 0; m < 4; ++m)
#pragma unroll
                for (int n = 0; n < 2; ++n) acc[a][b][m][n] = (f32x4){0.f, 0.f, 0.f, 0.f};
    bf16x8 At[4][2], B0[2][2], B1[2][2];
    const char* cA = g.abase(cur); const char* cB = g.bbase(cur);
    S.a_ready(cur);
    if constexpr (SP2) {
        PG8_STAGE(PG8_SB(0, 0), cB, voffB); PG8_STAGE(PG8_SB(0, 1), cB + hstep, voffB); PG8_STAGE(PG8_SA(0, 0), cA, voffA); PG8_STAGE(PG8_SA(0, 1), cA + hstep, voffA);
        if (wr == 1) PG8_BAR;
        PG8_WAIT_V(2); PG8_BAR;
        PG8_STAGE(PG8_SB(1, 0), cB + kstep, voffB); PG8_STAGE(PG8_SA(1, 0), cA + kstep, voffA); PG8_STAGE(PG8_SB(1, 1), cB + hstep + kstep, voffB);
        PG8_WAIT_V(6); PG8_BAR;
    } else {
        PG8_STAGE(PG8_SB(0, 0), cB, voffB); PG8_STAGE(PG8_SA(0, 0), cA, voffA); PG8_STAGE(PG8_SB(0, 1), cB + hstep, voffB); PG8_STAGE(PG8_SA(0, 1), cA + hstep, voffA);
        if (wr == 1) PG8_BAR;
        PG8_WAIT_V(4); PG8_BAR;
        PG8_STAGE(PG8_SB(1, 0), cB + kstep, voffB); PG8_STAGE(PG8_SA(1, 0), cA + kstep, voffA); PG8_STAGE(PG8_SB(1, 1), cB + hstep + kstep, voffB);
        PG8_WAIT_V(6); PG8_BAR;
    }
    for (;;) {
        const bool has_next = S.next(ui + 1, nxt);
        const char* nA = has_next ? g.abase(nxt) : cA; const char* nB = has_next ? g.bbase(nxt) : cB;
        for (int t = 0; t < nt; t += 2) {
            const bool last = (t == nt - 2);
            const char* a1 = cA + (size_t)(t + 1) * kstep;
            const char* a2 = last ? nA : cA + (size_t)(t + 2) * kstep; const char* b2 = last ? nB : cB + (size_t)(t + 2) * kstep;
            const char* a3 = a2 + kstep; const char* b3 = b2 + kstep;
            if (last && has_next) S.a_ready(nxt);
            if constexpr (SP2) {
            PG8_LDB(B0, 0, 0); PG8_LDB(B1, 0, 1); PG8_SCHED; PG8_LDA(At, 0, 0); PG8_STAGE(PG8_SA(1, 1), a1 + hstep, voffA);
            PG8_WAIT_V(8); PG8_WAIT_L(0); PG8_BAR; PG8_MMA(0, 0, At, B0); PG8_MMA(0, 1, At, B1); PG8_BAR; PG8_SCHED;
            PG8_LDA(At, 0, 1); PG8_STAGE(PG8_SB(0, 0), b2, voffB); PG8_STAGE(PG8_SB(0, 1), b2 + hstep, voffB); PG8_STAGE(PG8_SA(0, 0), a2, voffA);
            PG8_WAIT_V(8); PG8_WAIT_L(0); PG8_BAR; PG8_MMA(1, 0, At, B0); PG8_MMA(1, 1, At, B1); PG8_BAR; PG8_SCHED;
            PG8_LDB(B0, 1, 0); PG8_LDB(B1, 1, 1); PG8_SCHED; PG8_LDA(At, 1, 0); PG8_STAGE(PG8_SA(0, 1), a2 + hstep, voffA);
            PG8_WAIT_V(8); PG8_WAIT_L(0); PG8_BAR; PG8_MMA(0, 0, At, B0); PG8_MMA(0, 1, At, B1); PG8_BAR; PG8_SCHED;
            PG8_LDA(At, 1, 1); PG8_STAGE(PG8_SB(1, 0), b3, voffB); PG8_STAGE(PG8_SB(1, 1), b3 + hstep, voffB); PG8_STAGE(PG8_SA(1, 0), a3, voffA);
            PG8_WAIT_V(8); PG8_WAIT_L(0); PG8_BAR; PG8_MMA(1, 0, At, B0); PG8_MMA(1, 1, At, B1); PG8_BAR; PG8_SCHED;
            } else {
            PG8_LDB(B0, 0, 0); PG8_SCHED; PG8_LDA(At, 0, 0); PG8_STAGE(PG8_SA(1, 1), a1 + hstep, voffA);
            PG8_WAIT_L(8); PG8_BAR; PG8_WAIT_L(0); PG8_MMA(0, 0, At, B0); PG8_BAR; PG8_SCHED;
            PG8_LDB(B1, 0, 1); PG8_STAGE(PG8_SB(0, 0), b2, voffB);
            PG8_BAR; PG8_WAIT_L(0); PG8_MMA(0, 1, At, B1); PG8_BAR;
            PG8_LDA(At, 0, 1); PG8_STAGE(PG8_SA(0, 0), a2, voffA);
            PG8_BAR; PG8_WAIT_L(0); PG8_MMA(1, 0, At, B0); PG8_BAR; PG8_SCHED;
            PG8_STAGE(PG8_SB(0, 1), b2 + hstep, voffB);
            PG8_WAIT_V(6); PG8_BAR; PG8_MMA(1, 1, At, B1); PG8_BAR;
            PG8_LDB(B0, 1, 0); PG8_SCHED; PG8_LDA(At, 1, 0); PG8_STAGE(PG8_SA(0, 1), a2 + hstep, voffA);
            PG8_WAIT_L(8); PG8_BAR; PG8_WAIT_L(0); PG8_MMA(0, 0, At, B0); PG8_BAR; PG8_SCHED;
            PG8_LDB(B1, 1, 1); PG8_STAGE(PG8_SB(1, 0), b3, voffB);
            PG8_BAR; PG8_WAIT_L(0); PG8_MMA(0, 1, At, B1); PG8_BAR;
            PG8_LDA(At, 1, 1); PG8_STAGE(PG8_SA(1, 0), a3, voffA);
            PG8_BAR; PG8_WAIT_L(0); PG8_MMA(1, 0, At, B0); PG8_BAR; PG8_SCHED;
            PG8_STAGE(PG8_SB(1, 1), b3 + hstep, voffB);
            PG8_WAIT_V(6); PG8_BAR; PG8_MMA(1, 1, At, B1); PG8_BAR;
            }
        }
        if constexpr (ALIGN_EPI) { if (wr == 0) PG8_BAR; }
        if constexpr (!Epi::AFTER_DRAIN) { E(acc, cur, wr, wc, fr, fq); S.done(cur); }
        if (!has_next) break;
#pragma unroll
        for (int a = 0; a < 2; ++a)
#pragma unroll
            for (int b = 0; b < 2; ++b)
#pragma unroll
                for (int m = 0; m < 4; ++m)
#pragma unroll
                    for (int n = 0; n < 2; ++n) acc[a][b][m][n] = (f32x4){0.f, 0.f, 0.f, 0.f};
        cur = nxt; cA = nA; cB = nB; ++ui;
        if constexpr (ALIGN_EPI) { if (wr == 1) PG8_BAR; }
    }
    PG8_WAIT_V(0);
    if constexpr (!ALIGN_EPI) { if (wr == 0) PG8_BAR; }
    PG8_BAR;
    if constexpr (Epi::AFTER_DRAIN) { E.fused(acc, cur, wr, wc, fr, fq, lds, wid, lane); S.done(cur); }
#undef PG8_SA
#undef PG8_SB
#undef PG8_STAGE
#undef PG8_LDA
#undef PG8_LDB
#undef PG8_MMA
#undef PG8_WAIT_V
#undef PG8_WAIT_L
#undef PG8_BAR
#undef PG8_SCHED
}
}

using pg8::f32x4; using pg8::bf16x8; using pg8::u32x4; using pg8::Unit;
#define LAS __attribute__((address_space(3)))
typedef unsigned short bf16;
typedef unsigned u32x2 __attribute__((ext_vector_type(2)));
typedef float f32x2_t __attribute__((ext_vector_type(2)));
typedef __bf16 bf16x2_t __attribute__((ext_vector_type(2)));
#define LDS_WAIT() asm volatile("s_waitcnt lgkmcnt(0)" ::: "memory")

constexpr int NWAVES = 8, NTHR = 512;
constexpr int DM = 1024, NB = 8, SL = 2048, MT = NB * SL, LCX = 256, MCX = NB * LCX;
constexpr int INW = 5632, DFF = 2816, PWD = 512, NH = 8, DK = 64, DV = 128;
constexpr int Q_OFF = 512, K_OFF = 1024, V_OFF = 1536, G_OFF = 2560, GA_OFF = 3584, GB_OFF = 4608;
constexpr int NPOS = 18, NCH = 16, MODW = 6 * DM, NKC = 16;
constexpr float EPS = 1e-6f, LOG2E = 1.4426950408889634f;
constexpr int LDS_BYTES = 147456;
constexpr int NPHASE = 12;
#ifndef MK_REPS
#define MK_REPS {1,1,1,1,1,1,1,1,1,1,1,1}
#endif
__device__ constexpr int REPS[NPHASE] = MK_REPS;

constexpr size_t MiB = 1u << 20;
constexpr size_t WS_W13 = 1 * MiB, WS_W2 = 12 * MiB, WS_WCOMB = 17 * MiB + MiB / 2, WS_WRB = 18 * MiB + MiB / 2, WS_WO = 20 * MiB + MiB / 2;
constexpr size_t WS_MOD = 23 * MiB + MiB / 2, WS_Z = 24 * MiB, WS_MODP = WS_Z  , WS_SA = 200 * MiB, WS_END = 256 * MiB;
constexpr size_t WS_WIN = WS_SA, WS_H = WS_SA + 11 * MiB, WS_HC = WS_SA + 43 * MiB, WS_ZC = WS_SA + 47 * MiB;
constexpr size_t WS_D = WS_SA, WS_ST = WS_SA + 16 * MiB, WS_MERGED = WS_SA + 16 * MiB, WS_H2 = WS_SA, WS_HMID = WS_Z;
static_assert(WS_ZC + (size_t)MCX * 1536 * 2 <= WS_END && WS_ST + (size_t)64 * 16 * 16384 * 2 <= WS_END && WS_Z + (size_t)MT * INW * 2 <= WS_SA, "ws map");
static_assert((size_t)64 * NPOS * 16384 * 2 <= (size_t)MT * DM * 4, "ws map 2");

__device__ __forceinline__ unsigned pk2(float lo, float hi) { f32x2_t v = {lo, hi}; bf16x2_t b = __builtin_convertvector(v, bf16x2_t); return __builtin_bit_cast(unsigned, b); }
__device__ __forceinline__ bf16 f2bf(float f) { return (bf16)(pk2(f, 0.f) & 0xffffu); }
__device__ __forceinline__ float bflo(unsigned u) { return __uint_as_float(u << 16); }
__device__ __forceinline__ float bfhi(unsigned u) { return __uint_as_float(u & 0xffff0000u); }
__device__ __forceinline__ float bf1(bf16 v) { return __uint_as_float((unsigned)v << 16); }
__device__ __forceinline__ float wave_sum(float v) {
#pragma unroll
    for (int o = 1; o < 64; o <<= 1) v += __shfl_xor(v, o);
    return v;
}
__device__ __forceinline__ float sigmoid_(float x) { return __builtin_amdgcn_rcpf(1.f + __builtin_amdgcn_exp2f(-x * LOG2E)); }
__device__ __forceinline__ float silu_(float x) { return x * sigmoid_(x); }
__device__ __forceinline__ float ex2(float x) { return __builtin_amdgcn_exp2f(x); }
__device__ __forceinline__ float log2_sigmoid(float x) { return -log1pf(expf(-x)) * LOG2E; }
__device__ __forceinline__ void unpack8(const u32x4 r, float (&f)[8]) {
    f[0] = bflo(r.x); f[1] = bfhi(r.x); f[2] = bflo(r.y); f[3] = bfhi(r.y); f[4] = bflo(r.z); f[5] = bfhi(r.z); f[6] = bflo(r.w); f[7] = bfhi(r.w);
}
__device__ __forceinline__ u32x4 pack8(const float (&f)[8]) { u32x4 o; o.x = pk2(f[0], f[1]); o.y = pk2(f[2], f[3]); o.z = pk2(f[4], f[5]); o.w = pk2(f[6], f[7]); return o; }

struct EpiZ {
    static constexpr bool PERM = true, AFTER_DRAIN = false;
    bf16* Z; bf16* ZC;
    __device__ __forceinline__ void operator()(const f32x4 (&acc)[2][2][4][2], const Unit& u, int wr, int wc, int fr, int fq) const {
        bf16* base = u.g ? ZC : Z; const int ldc = u.g ? 1536 : INW; const bool sig = (u.g == 0) && (u.pn >= GA_OFF / 256);
        const int row0 = u.pm * 256 + wr * 64 + fr, col0 = u.pn * 256 + wc * 32 + 8 * fq;
#pragma unroll
        for (int ai = 0; ai < 2; ++ai)
#pragma unroll
            for (int m = 0; m < 4; ++m) { bf16* rowp = base + (size_t)(row0 + ai * 128 + m * 16) * ldc + col0;
#pragma unroll
                for (int bj = 0; bj < 2; ++bj) { f32x4 v0 = acc[ai][bj][m][0], v1 = acc[ai][bj][m][1];
                    if (sig) {
#pragma unroll
                        for (int e = 0; e < 4; ++e) { v0[e] = sigmoid_(v0[e]); v1[e] = sigmoid_(v1[e]); } }
                    u32x4 w; w.x = pk2(v0[0], v0[1]); w.y = pk2(v0[2], v0[3]); w.z = pk2(v1[0], v1[1]); w.w = pk2(v1[2], v1[3]);
                    *(u32x4*)(rowp + bj * 128) = w; } }
    }
};
template <bool ADD> struct EpiGate {
    static constexpr bool PERM = true, AFTER_DRAIN = false;
    const bf16* Z; int goff; bf16* O;
    __device__ __forceinline__ void operator()(const f32x4 (&acc)[2][2][4][2], const Unit& u, int wr, int wc, int fr, int fq) const {
        const int row0 = u.pm * 256 + wr * 64 + fr, col0 = u.pn * 256 + wc * 32 + 8 * fq;
#pragma unroll
        for (int ai = 0; ai < 2; ++ai) {
            u32x4 gt[4][2], ov[4][2];
#pragma unroll
            for (int m = 0; m < 4; ++m)
#pragma unroll
                for (int bj = 0; bj < 2; ++bj) { const size_t row = (size_t)(row0 + ai * 128 + m * 16); const int col = col0 + bj * 128;
                    gt[m][bj] = *(const u32x4*)(Z + row * INW + goff + col); if (ADD) ov[m][bj] = *(const u32x4*)(O + row * DM + col); }
#pragma unroll
            for (int m = 0; m < 4; ++m)
#pragma unroll
                for (int bj = 0; bj < 2; ++bj) { const size_t row = (size_t)(row0 + ai * 128 + m * 16); const int col = col0 + bj * 128;
                    float g[8], o[8]; unpack8(gt[m][bj], g); if (ADD) unpack8(ov[m][bj], o);
#pragma unroll
                    for (int e = 0; e < 8; ++e) { const float a = acc[ai][bj][m][e >> 2][e & 3]; o[e] = ADD ? (o[e] + g[e] * a) : (g[e] * a); }
                    *(u32x4*)(O + row * DM + col) = pack8(o); }
        }
    }
};
struct EpiRes {
    static constexpr bool PERM = true, AFTER_DRAIN = false;
    const float* base; float* out; const float* mod; int goff;
    __device__ __forceinline__ void operator()(const f32x4 (&acc)[2][2][4][2], const Unit& u, int wr, int wc, int fr, int fq) const {
        const int row0 = u.pm * 256 + wr * 64 + fr, col0 = u.pn * 256 + wc * 32 + 8 * fq, b = u.pm >> 3;
        const float* gp = mod + (size_t)b * MODW + goff + col0;
        f32x4 gv[2][2];
#pragma unroll
        for (int bj = 0; bj < 2; ++bj)
#pragma unroll
            for (int n = 0; n < 2; ++n) gv[bj][n] = *(const f32x4*)(gp + bj * 128 + 4 * n);
#pragma unroll
        for (int ai = 0; ai < 2; ++ai) {
            f32x4 bv[4][2][2];
#pragma unroll
            for (int m = 0; m < 4; ++m)
#pragma unroll
                for (int bj = 0; bj < 2; ++bj)
#pragma unroll
                    for (int n = 0; n < 2; ++n) bv[m][bj][n] = *(const f32x4*)(base + (size_t)(row0 + ai * 128 + m * 16) * DM + col0 + bj * 128 + 4 * n);
#pragma unroll
            for (int m = 0; m < 4; ++m)
#pragma unroll
                for (int bj = 0; bj < 2; ++bj)
#pragma unroll
                    for (int n = 0; n < 2; ++n) *(f32x4*)(out + (size_t)(row0 + ai * 128 + m * 16) * DM + col0 + bj * 128 + 4 * n) = bv[m][bj][n] + gv[bj][n] * acc[ai][bj][m][n];
        }
    }
};
struct EpiSwiglu {
    static constexpr bool PERM = true, AFTER_DRAIN = false;
    bf16* O;
    __device__ __forceinline__ void operator()(const f32x4 (&acc)[2][2][4][2], const Unit& u, int wr, int wc, int fr, int fq) const {
        const int row0 = u.pm * 256 + wr * 64 + fr, col0 = u.pn * 128 + wc * 32 + 8 * fq;
#pragma unroll
        for (int ai = 0; ai < 2; ++ai)
#pragma unroll
            for (int m = 0; m < 4; ++m) { float o[8];
#pragma unroll
                for (int e = 0; e < 8; ++e) o[e] = silu_(acc[ai][0][m][e >> 2][e & 3]) * acc[ai][1][m][e >> 2][e & 3];
                *(u32x4*)(O + (size_t)(row0 + ai * 128 + m * 16) * DFF + col0) = pack8(o); }
    }
};

__device__ __forceinline__ void transpose_item(const float* __restrict__ W, int K, int N, bf16* WT, int mode, LAS float* scr, int item, int lane) {
    const int nblk = N / 32, kb = item / nblk, nb = item % nblk, k0 = 64 * kb, n0 = 32 * nb;
    float tv[32];
#pragma unroll
    for (int i = 0; i < 32; ++i) tv[i] = W[(size_t)(k0 + 2 * i + (lane >> 5)) * N + n0 + (lane & 31)];
#pragma unroll
    for (int i = 0; i < 32; ++i) scr[(2 * i + (lane >> 5)) * 33 + (lane & 31)] = tv[i];
    LDS_WAIT(); asm volatile("" ::: "memory");
    const int c = lane & 7;
    const int drow0 = (mode == 0) ? n0 : (256 * (n0 >> 7) + (n0 & 127) + (mode == 2 ? 128 : 0));
#pragma unroll
    for (int j = 0; j < 4; ++j) { const int n = (lane >> 3) + 8 * j; const LAS float* s = scr + (8 * c) * 33 + n;
        u32x4 o; o.x = pk2(s[0 * 33], s[1 * 33]); o.y = pk2(s[2 * 33], s[3 * 33]); o.z = pk2(s[4 * 33], s[5 * 33]); o.w = pk2(s[6 * 33], s[7 * 33]);
        *(u32x4*)(WT + (size_t)(drow0 + n) * K + k0 + 8 * c) = o; }
    LDS_WAIT(); asm volatile("" ::: "memory");
}
__device__ __forceinline__ void wcomb_item(const float* __restrict__ w_pool, const float* __restrict__ pscale, const float* __restrict__ w_pa, bf16* WcT, int item, int lane) {
    const int g = item >> 7, rem = item & 127, n = (rem >> 3) * 64 + lane, c0 = (rem & 7) * 16;
    float wcol[128];
#pragma unroll
    for (int d = 0; d < 128; ++d) wcol[d] = w_pa[(size_t)(g * 128 + d) * DM + n];
#pragma unroll
    for (int d = 0; d < 128; ++d) wcol[d] *= pscale[g * 128 + d];
    float res[16];
#pragma unroll 2
    for (int cc = 0; cc < 16; ++cc) { const float* wr = w_pool + (size_t)(g * 128 + c0 + cc) * 128; float a0 = 0.f, a1 = 0.f;
#pragma unroll
        for (int d = 0; d < 128; d += 2) { a0 += wr[d] * wcol[d]; a1 += wr[d + 1] * wcol[d + 1]; }
        res[cc] = a0 + a1; }
    u32x4 o0, o1; o0.x = pk2(res[0], res[1]); o0.y = pk2(res[2], res[3]); o0.z = pk2(res[4], res[5]); o0.w = pk2(res[6], res[7]);
    o1.x = pk2(res[8], res[9]); o1.y = pk2(res[10], res[11]); o1.z = pk2(res[12], res[13]); o1.w = pk2(res[14], res[15]);
    bf16* op = WcT + (size_t)n * PWD + g * 128 + c0; *(u32x4*)op = o0; *(u32x4*)(op + 8) = o1;
}
__device__ __forceinline__ void ada_item(const float* __restrict__ cnd, const float* __restrict__ cctx, const float* __restrict__ w_ada, float* MODP, int item, int lane) {
    const int cb = item % 96, kc = item / 96, col = cb * 64 + lane, kb = kc * 64;
    float wv[64];
    const float* wp = w_ada + (size_t)kb * MODW + col;
#pragma unroll
    for (int kk = 0; kk < 64; ++kk) wv[kk] = wp[(size_t)kk * MODW];
    float sv[9], acc[9];
#pragma unroll
    for (int b = 0; b < 9; ++b) { const float x = (b < 8) ? cnd[b * DM + kb + lane] : cctx[kb + lane]; sv[b] = x / (1.f + expf(-x)); acc[b] = 0.f; }
#pragma unroll
    for (int kk = 0; kk < 64; ++kk) {
#pragma unroll
        for (int b = 0; b < 9; ++b) acc[b] += __int_as_float(__builtin_amdgcn_readlane(__float_as_int(sv[b]), kk)) * wv[kk]; }
#pragma unroll
    for (int b = 0; b < 9; ++b) MODP[((size_t)kc * 9 + b) * MODW + col] = acc[b];
}

template <int U> __device__ __forceinline__ void norm_rows_bf16(const float* src0, bf16* dst0, int r, int rend, int rstride, const f32x4 (&gs)[4], const f32x4 (&sh)[4], int lane) {
    for (; r < rend; r += U * rstride) {
        f32x4 v[U][4];
#pragma unroll
        for (int u = 0; u < U; ++u) if (r + u * rstride < rend) {
#pragma unroll
            for (int j = 0; j < 4; ++j) v[u][j] = *(const f32x4*)(src0 + (size_t)(r + u * rstride) * DM + 4 * lane + 256 * j); }
#pragma unroll
        for (int u = 0; u < U; ++u) if (r + u * rstride < rend) {
            float ss = 0.f;
#pragma unroll
            for (int j = 0; j < 4; ++j) ss += (v[u][j].x * v[u][j].x + v[u][j].y * v[u][j].y) + (v[u][j].z * v[u][j].z + v[u][j].w * v[u][j].w);
            const float rstd = rsqrtf(wave_sum(ss) * (1.f / DM) + EPS);
            bf16* dst = dst0 + (size_t)(r + u * rstride) * DM;
#pragma unroll
            for (int j = 0; j < 4; ++j) { const f32x4 o = v[u][j] * rstd * gs[j] + sh[j]; u32x2 w; w.x = pk2(o.x, o.y); w.y = pk2(o.z, o.w); *(u32x2*)(dst + 4 * lane + 256 * j) = w; } }
    }
}
__device__ __forceinline__ void p1_norm(LAS unsigned char* lds, const float* __restrict__ x, const float* __restrict__ ctx, const float* __restrict__ gain, const float* __restrict__ b_ada, const float* MODP,
                                         bf16* H, bf16* HC, int bx, int G, int tid, int wave, int lane) {
    LAS float* tab = (LAS float*)lds;
    const int total = MT + MCX, per = (total + G - 1) / G, r1 = ((bx + 1) * per < total) ? (bx + 1) * per : total;
    int r = bx * per;
    while (r < r1) {
        const int b = (r < MT) ? (r >> 11) : 8, bend = (b < 8) ? (b + 1) * SL : total, rend = (r1 < bend) ? r1 : bend;
        {   const int col = 2 * tid; f32x2_t s = *(const f32x2_t*)(b_ada + col), c = *(const f32x2_t*)(b_ada + DM + col);
#pragma unroll
            for (int kc = 0; kc < NKC; ++kc) { s += *(const f32x2_t*)(MODP + ((size_t)kc * 9 + b) * MODW + col); c += *(const f32x2_t*)(MODP + ((size_t)kc * 9 + b) * MODW + DM + col); }
            const f32x2_t g = *(const f32x2_t*)(gain + col);
            tab[col] = g.x * (1.f + c.x); tab[col + 1] = g.y * (1.f + c.y); tab[DM + col] = s.x; tab[DM + col + 1] = s.y; }
        __syncthreads();
        f32x4 gs[4], sh[4];
#pragma unroll
        for (int j = 0; j < 4; ++j) { gs[j] = *(const LAS f32x4*)(tab + 4 * lane + 256 * j); sh[j] = *(const LAS f32x4*)(tab + DM + 4 * lane + 256 * j); }
        if (b < 8) norm_rows_bf16<3>(x, H, r + wave, rend, NWAVES, gs, sh, lane);
        else norm_rows_bf16<3>(ctx - (size_t)MT * DM, HC - (size_t)MT * DM, r + wave, rend, NWAVES, gs, sh, lane);
        __syncthreads();
        r = rend;
    }
}
__device__ __forceinline__ void p8_norm(const float* x1, const float* __restrict__ gain, const float* MOD, bf16* H2, int bx, int G, int wave, int lane) {
    const int per = (MT + G - 1) / G, r1 = ((bx + 1) * per < MT) ? (bx + 1) * per : MT;
    int r = bx * per;
    while (r < r1) {
        const int b = r >> 11, bend = (b + 1) * SL, rend = (r1 < bend) ? r1 : bend;
        f32x4 gs[4], sh[4];
#pragma unroll
        for (int j = 0; j < 4; ++j) { const int col = 4 * lane + 256 * j;
            const f32x4 s = *(const f32x4*)(MOD + (size_t)b * MODW + 3 * DM + col), c = *(const f32x4*)(MOD + (size_t)b * MODW + 4 * DM + col), g = *(const f32x4*)(gain + col);
            sh[j] = s; gs[j] = g * (c + 1.0f); }
        norm_rows_bf16<4>(x1, H2, r + wave, rend, NWAVES, gs, sh, lane);
        r = rend;
    }
}
__device__ __forceinline__ void p11_norm(float* out, const float* __restrict__ gain, int gw, int NGW, int lane) {
    f32x4 g[4];
#pragma unroll
    for (int j = 0; j < 4; ++j) g[j] = *(const f32x4*)(gain + 4 * lane + 256 * j);
    constexpr int U = 4;
    for (int r = gw; r < MT; r += U * NGW) {
        f32x4 v[U][4];
#pragma unroll
        for (int u = 0; u < U; ++u) if (r + u * NGW < MT) {
#pragma unroll
            for (int j = 0; j < 4; ++j) v[u][j] = *(const f32x4*)(out + (size_t)(r + u * NGW) * DM + 4 * lane + 256 * j); }
#pragma unroll
        for (int u = 0; u < U; ++u) if (r + u * NGW < MT) {
            float ss = 0.f;
#pragma unroll
            for (int j = 0; j < 4; ++j) ss += (v[u][j].x * v[u][j].x + v[u][j].y * v[u][j].y) + (v[u][j].z * v[u][j].z + v[u][j].w * v[u][j].w);
            const float rstd = rsqrtf(wave_sum(ss) * (1.f / DM) + EPS);
            float* p = out + (size_t)(r + u * NGW) * DM;
#pragma unroll
            for (int j = 0; j < 4; ++j) *(f32x4*)(p + 4 * lane + 256 * j) = v[u][j] * rstd * g[j]; }
    }
}

__device__ __forceinline__ int vt_off(int v, int j) { return v * 272 + ((((j >> 3) ^ (v >> 3)) & 15) << 4) + (j & 7) * 2; }
__device__ __forceinline__ void vt_write(LAS unsigned char* vt, const u32x4 (&r)[4], int tid) {
    const int vseg = tid & 15, j0 = (tid >> 4) * 4;
#pragma unroll
    for (int e2 = 0; e2 < 4; ++e2) {
        const unsigned a0 = r[0][e2], a1 = r[1][e2], a2 = r[2][e2], a3 = r[3][e2];
        u32x2 lo, hi; lo.x = (a0 & 0xffffu) | (a1 << 16); lo.y = (a2 & 0xffffu) | (a3 << 16); hi.x = (a0 >> 16) | (a1 & 0xffff0000u); hi.y = (a2 >> 16) | (a3 & 0xffff0000u);
        const int v = vseg * 8 + 2 * e2;
        *(LAS u32x2*)(vt + vt_off(v, j0)) = lo; *(LAS u32x2*)(vt + vt_off(v + 1, j0)) = hi;
    }
}
__device__ __forceinline__ void stage_vt(LAS unsigned char* vt, const bf16* vbase, int ld, int tid) {
    const int vseg = tid & 15, j0 = (tid >> 4) * 4;
    u32x4 r[4];
#pragma unroll
    for (int jj = 0; jj < 4; ++jj) r[jj] = *(const u32x4*)(vbase + (size_t)(j0 + jj) * ld + vseg * 8);
#pragma unroll
    for (int e2 = 0; e2 < 4; ++e2) {
        const unsigned a0 = r[0][e2], a1 = r[1][e2], a2 = r[2][e2], a3 = r[3][e2];
        u32x2 lo, hi; lo.x = (a0 & 0xffffu) | (a1 << 16); lo.y = (a2 & 0xffffu) | (a3 << 16); hi.x = (a0 >> 16) | (a1 & 0xffff0000u); hi.y = (a2 >> 16) | (a3 & 0xffff0000u);
        const int v = vseg * 8 + 2 * e2;
        *(LAS u32x2*)(vt + vt_off(v, j0)) = lo; *(LAS u32x2*)(vt + vt_off(v + 1, j0)) = hi;
    }
}
__device__ __forceinline__ void rope_cs(int tok, int f, float& cs, float& sn) {
    const float pos = (float)((f < 16) ? (tok >> 6) : (tok & 63));
    const float ang = pos * ex2(-(float)(f & 15) * 0.8304820237218406f);
    cs = __cosf(ang); sn = __sinf(ang);
}
#define WG_BARRIER() do { asm volatile("s_waitcnt lgkmcnt(0)" ::: "memory"); __builtin_amdgcn_s_barrier(); asm volatile("" ::: "memory"); } while (0)
struct APre { u32x4 v[4]; u32x4 k[8]; };
__device__ __forceinline__ void a_load(APre& p, const bf16* Z, const bf16* ZC, int it, int tid) {
    const int bh = it / NPOS, pos = it % NPOS, b = bh >> 3, h = bh & 7; const bool lat = pos >= 2; const int c = pos - 2;
    const bf16* kbase = lat ? Z + ((size_t)b * SL + c * 128) * INW + K_OFF + h * DK : ZC + ((size_t)b * LCX + pos * 128) * 1536 + h * DK;
    const bf16* vbase = lat ? Z + ((size_t)b * SL + c * 128) * INW + V_OFF + h * DV : ZC + ((size_t)b * LCX + pos * 128) * 1536 + 512 + h * DV;
    const int ld = lat ? INW : 1536;
#pragma unroll
    for (int jj = 0; jj < 4; ++jj) p.v[jj] = *(const u32x4*)(vbase + (size_t)((tid >> 4) * 4 + jj) * ld + (tid & 15) * 8);
    if (tid < 256) { const int tt = tid & 127, j0 = (tt >> 2) * 4, d0 = (tt & 3) * 8;
#pragma unroll
        for (int jj = 0; jj < 4; ++jj) { p.k[2 * jj] = *(const u32x4*)(kbase + (size_t)(j0 + jj) * ld + d0); p.k[2 * jj + 1] = *(const u32x4*)(kbase + (size_t)(j0 + jj) * ld + 32 + d0); } }
}
__device__ __forceinline__ void a_item(LAS unsigned char* lds, APre& pre, const bf16* Z, const bf16* ZC, bf16* AT, const float* __restrict__ dec_f, const float* __restrict__ dec_b, int it, int nxt, int tid, int wave, int lane) {
    asm volatile("" : "+v"(tid), "+v"(lane));
    LAS unsigned char* Vt = lds; LAS unsigned char* Kt = lds + 34816;
    const int bh = it / NPOS, pos = it % NPOS, h = bh & 7; const bool lat = pos >= 2; const int c = pos - 2;
    vt_write(Vt, pre.v, tid);
    if (tid < 256) {
        const int tt = tid & 127, dir = tid >> 7, j0 = (tt >> 2) * 4, d0 = (tt & 3) * 8;
        const float lg2 = log2_sigmoid(dir ? dec_b[h] : dec_f[h]);
        unsigned p1[8][2], p2[8][2];
#pragma unroll
        for (int jp = 0; jp < 2; ++jp) {
            float o1[2][8], o2[2][8];
#pragma unroll
            for (int q = 0; q < 2; ++q) { const int j = j0 + 2 * jp + q;
                float x1[8], x2[8]; unpack8(pre.k[2 * (2 * jp + q)], x1); unpack8(pre.k[2 * (2 * jp + q) + 1], x2);
                const float dec = ex2(lg2 * (float)(dir ? j : 127 - j)) * 0.125f;
#pragma unroll
                for (int e = 0; e < 8; ++e) {
                    float a = x1[e], bb = x2[e];
                    if (lat) { float cs, sn; rope_cs(c * 128 + j, d0 + e, cs, sn); const float t1 = a * cs - bb * sn, t2 = a * sn + bb * cs; a = t1; bb = t2; }
                    o1[q][e] = a * dec; o2[q][e] = bb * dec; } }
#pragma unroll
            for (int e = 0; e < 8; ++e) { p1[e][jp] = pk2(o1[0][e], o1[1][e]); p2[e][jp] = pk2(o2[0][e], o2[1][e]); }
        }
#pragma unroll
        for (int e = 0; e < 8; ++e) { u32x2 w1, w2; w1.x = p1[e][0]; w1.y = p1[e][1]; w2.x = p2[e][0]; w2.y = p2[e][1];
            *(LAS u32x2*)(Kt + vt_off(dir * 64 + d0 + e, j0)) = w1; *(LAS u32x2*)(Kt + vt_off(dir * 64 + 32 + d0 + e, j0)) = w2; }
    }
    if (nxt >= 0) a_load(pre, Z, ZC, nxt, tid);
    WG_BARRIER();
    const int fr = lane & 15, fq = lane >> 4;
    f32x4 acc[8];
#pragma unroll
    for (int ct = 0; ct < 8; ++ct) acc[ct] = (f32x4){0.f, 0.f, 0.f, 0.f};
#pragma unroll
    for (int ks = 0; ks < 4; ++ks) {
        const bf16x8 a = *(const LAS bf16x8*)(Vt + vt_off(16 * wave + fr, 32 * ks + 8 * fq));
#pragma unroll
        for (int ct = 0; ct < 8; ++ct) { const bf16x8 bb = *(const LAS bf16x8*)(Kt + vt_off(16 * ct + fr, 32 * ks + 8 * fq)); acc[ct] = __builtin_amdgcn_mfma_f32_16x16x32_bf16(a, bb, acc[ct], 0, 0, 0); }
    }
#pragma unroll
    for (int ct = 0; ct < 8; ++ct)
#pragma unroll
        for (int r = 0; r < 4; ++r) *(LAS bf16*)(Vt + (16 * wave + 4 * fq + r) * 272 + (16 * ct + fr) * 2) = f2bf(acc[ct][r]);
    asm volatile("s_waitcnt lgkmcnt(0)" ::: "memory");
    bf16* ob = AT + (size_t)it * 16384;
#pragma unroll
    for (int i = 0; i < 4; ++i) { const int idx = lane + 64 * i, row = 16 * wave + (idx >> 4), seg = idx & 15;
        *(u32x4*)(ob + row * 128 + seg * 8) = *(const LAS u32x4*)(Vt + row * 272 + seg * 16); }
    WG_BARRIER();
}
template <int GG> __device__ __forceinline__ void pool_item(LAS unsigned char* lds, const bf16* Z, bf16* Db, int b, int r, int tid) {
    constexpr int hw = 1 << GG, W = 2 * hw, SLAB = (W < 8) ? W : 8;
    asm volatile("" : "+v"(tid));
    LAS float* cs = (LAS float*)lds;
    const int c = tid >> 3, sg = tid & 7, ch0 = GG * 128 + sg * 8;
    const int rlo = (r - hw > 0) ? r - hw : 0, rhi = (r + hw < 32) ? r + hw : 32, clo = (c - hw > 0) ? c - hw : 0, chi = (c + hw < 64) ? c + hw : 64;
    float sum[16], own[16];
#pragma unroll
    for (int e = 0; e < 16; ++e) { sum[e] = 0.f; own[e] = 0.f; }
    const bf16* zb = Z + ((size_t)b * SL + c) * INW + ch0;
#pragma unroll
    for (int k0 = 0; k0 < W; k0 += SLAB) {
        u32x4 xa[SLAB], xb[SLAB];
#pragma unroll
        for (int k = 0; k < SLAB; ++k) { const int rr = r - hw + k0 + k, rc = ((unsigned)rr < 32u) ? rr : r; const bf16* zp = zb + (size_t)rc * 64 * INW; xa[k] = *(const u32x4*)zp; xb[k] = *(const u32x4*)(zp + 64); }
#pragma unroll
        for (int k = 0; k < SLAB; ++k) { const int rr = r - hw + k0 + k; const float m = ((unsigned)rr < 32u) ? 1.f : 0.f;
            float x[8], y[8]; unpack8(xa[k], x); unpack8(xb[k], y);
#pragma unroll
            for (int e = 0; e < 8; ++e) { sum[e] += m * x[e]; sum[8 + e] += m * y[e]; if (k0 + k == hw) { own[e] = x[e]; own[8 + e] = y[e]; } } }
    }
#pragma unroll
    for (int q = 0; q < 4; ++q) *(LAS f32x4*)(cs + c * 132 + (q >> 1) * 64 + sg * 8 + (q & 1) * 4) = (f32x4){sum[4 * q], sum[4 * q + 1], sum[4 * q + 2], sum[4 * q + 3]};
    __syncthreads();
    f32x4 hs[4];
#pragma unroll
    for (int q = 0; q < 4; ++q) hs[q] = (f32x4){0.f, 0.f, 0.f, 0.f};
#pragma unroll
    for (int k = 0; k < W; ++k) { const int cc = c - hw + k, ccl = ((unsigned)cc < 64u) ? cc : c; const float m = ((unsigned)cc < 64u) ? 1.f : 0.f;
#pragma unroll
        for (int q = 0; q < 4; ++q) hs[q] += *(const LAS f32x4*)(cs + ccl * 132 + (q >> 1) * 64 + sg * 8 + (q & 1) * 4) * m; }
    const float inv = 1.f / (float)((rhi - rlo) * (chi - clo));
    float o0[8], o1[8];
#pragma unroll
    for (int e = 0; e < 4; ++e) { o0[e] = hs[0][e] * inv - own[e]; o0[4 + e] = hs[1][e] * inv - own[4 + e]; o1[e] = hs[2][e] * inv - own[8 + e]; o1[4 + e] = hs[3][e] * inv - own[12 + e]; }
    bf16* dp = Db + ((size_t)b * SL + r * 64 + c) * PWD + ch0;
    *(u32x4*)dp = pack8(o0); *(u32x4*)(dp + 64) = pack8(o1);
    __syncthreads();
}
__device__ __forceinline__ void scan_item(const bf16* AT, bf16* ST, float lgf2, float lgb2, int bh, int q, int tid) {
    const int e0 = q * 4096 + tid * 8; const bool dirb = ((tid & 15) >= 8);
    const float cd = ex2((dirb ? lgb2 : lgf2) * 128.f);
    const bf16* ab = AT + (size_t)bh * NPOS * 16384 + e0; bf16* sb = ST + (size_t)bh * NCH * 16384 + e0;
    float S[8];
#pragma unroll
    for (int e = 0; e < 8; ++e) S[e] = 0.f;
#pragma unroll
    for (int s = 0; s < NPOS; ++s) {
        if (s >= 2) { const int cc = dirb ? 17 - s : s - 2; *(u32x4*)(sb + (size_t)cc * 16384) = pack8(S); }
        if (s < NPOS - 1) { const int posr = dirb ? (s < 2 ? 1 - s : 19 - s) : s; float a[8]; unpack8(*(const u32x4*)(ab + (size_t)posr * 16384), a);
#pragma unroll
            for (int e = 0; e < 8; ++e) S[e] = cd * S[e] + a[e]; }
    }
}
struct R3Pre { u32x4 q1, q2, k1, k2, v[4]; };
__device__ __forceinline__ void r3_load(R3Pre& p, const bf16* Z, const bf16* ST, int it, int tid, int wave, int lane) {
    const int bh = it >> 4, c = it & 15, b = bh >> 3, h = bh & 7; const size_t grow0 = (size_t)b * SL + c * 128;
    {   const bf16* zr = Z + (grow0 + (tid >> 2)) * INW + h * DK + (tid & 3) * 8;
        p.q1 = *(const u32x4*)(zr + Q_OFF); p.q2 = *(const u32x4*)(zr + Q_OFF + 32); p.k1 = *(const u32x4*)(zr + K_OFF); p.k2 = *(const u32x4*)(zr + K_OFF + 32); }
    {   const bf16* vb = Z + (grow0 + (tid >> 4) * 4) * INW + V_OFF + h * DV + (tid & 15) * 8;
#pragma unroll
        for (int jj = 0; jj < 4; ++jj) p.v[jj] = *(const u32x4*)(vb + (size_t)jj * INW); }
}
__device__ __forceinline__ void r3_item(LAS unsigned char* lds, R3Pre& pre, const bf16* Z, const bf16* ST, bf16* YN, const float* __restrict__ gnw, const float* __restrict__ dec_f, const float* __restrict__ dec_b,
                                         int it, int nxt, int tid, int wave, int lane) {
    asm volatile("" : "+v"(tid), "+v"(lane));
    LAS unsigned char* Qs = lds; LAS unsigned char* Ks = lds + 18432; LAS unsigned char* Vt = lds + 36864; LAS unsigned char* Ps = lds + 71680; LAS unsigned char* Ss = lds + 106496;
    const int bh = it >> 4, c = it & 15, b = bh >> 3, h = bh & 7;
    const float lgf2 = log2_sigmoid(dec_f[h]), lgb2 = log2_sigmoid(dec_b[h]);
    const size_t grow0 = (size_t)b * SL + c * 128;
    u32x4 stv[4], gcur[4];
    {   const bf16* sp = ST + ((size_t)(bh * NCH + c)) * 16384;
#pragma unroll
        for (int i = 0; i < 4; ++i) { const int idx = tid + NTHR * i; stv[i] = *(const u32x4*)(sp + (idx >> 4) * 128 + (idx & 15) * 8); } }
#pragma unroll
    for (int i = 0; i < 4; ++i) { const int idx = lane + 64 * i; gcur[i] = *(const u32x4*)(Z + (grow0 + 16 * wave + (idx >> 4)) * INW + G_OFF + h * DV + (idx & 15) * 8); }
    {
        const int row = tid >> 2, d0 = (tid & 3) * 8, tok = c * 128 + row;
        float q1[8], q2[8], k1[8], k2[8];
        unpack8(pre.q1, q1); unpack8(pre.q2, q2); unpack8(pre.k1, k1); unpack8(pre.k2, k2);
        float qa[8], qb[8], ka[8], kb[8];
#pragma unroll
        for (int e = 0; e < 8; ++e) { float cs, sn; rope_cs(tok, d0 + e, cs, sn);
            qa[e] = q1[e] * cs - q2[e] * sn; qb[e] = q1[e] * sn + q2[e] * cs;
            ka[e] = (k1[e] * cs - k2[e] * sn) * 0.125f; kb[e] = (k1[e] * sn + k2[e] * cs) * 0.125f; }
        *(LAS u32x4*)(Qs + row * 144 + d0 * 2) = pack8(qa); *(LAS u32x4*)(Qs + row * 144 + (32 + d0) * 2) = pack8(qb);
        *(LAS u32x4*)(Ks + row * 144 + d0 * 2) = pack8(ka); *(LAS u32x4*)(Ks + row * 144 + (32 + d0) * 2) = pack8(kb);
    }
    vt_write(Vt, pre.v, tid);
#pragma unroll
    for (int i = 0; i < 4; ++i) { const int idx = tid + NTHR * i; *(LAS u32x4*)(Ss + (idx >> 4) * 272 + (idx & 15) * 16) = stv[i]; }
    if (nxt >= 0) r3_load(pre, Z, ST, nxt, tid, wave, lane);
    WG_BARRIER();
    const int fr = lane & 15, fq = lane >> 4, i0 = 16 * wave;
    f32x4 s[8];
#pragma unroll
    for (int ct = 0; ct < 8; ++ct) s[ct] = (f32x4){0.f, 0.f, 0.f, 0.f};
#pragma unroll
    for (int ks = 0; ks < 2; ++ks) {
        const bf16x8 a = *(const LAS bf16x8*)(Qs + (i0 + fr) * 144 + (32 * ks + 8 * fq) * 2);
#pragma unroll
        for (int ct = 0; ct < 8; ++ct) { const bf16x8 bb = *(const LAS bf16x8*)(Ks + (16 * ct + fr) * 144 + (32 * ks + 8 * fq) * 2); s[ct] = __builtin_amdgcn_mfma_f32_16x16x32_bf16(a, bb, s[ct], 0, 0, 0); }
    }
#pragma unroll
    for (int ct = 0; ct < 8; ++ct)
#pragma unroll
        for (int r = 0; r < 4; ++r) { const int i = i0 + 4 * fq + r, j = 16 * ct + fr, df = i - j;
            const float dv = ex2(df >= 0 ? lgf2 * (float)df : lgb2 * (float)(-df));
            *(LAS bf16*)(Ps + i * 272 + j * 2) = f2bf(s[ct][r] * dv); }
    asm volatile("s_waitcnt lgkmcnt(0)" ::: "memory");
    f32x4 o[8];
#pragma unroll
    for (int vt = 0; vt < 8; ++vt) o[vt] = (f32x4){0.f, 0.f, 0.f, 0.f};
#pragma unroll
    for (int ks = 0; ks < 4; ++ks) {
        const bf16x8 a = *(const LAS bf16x8*)(Ps + (i0 + fr) * 272 + (32 * ks + 8 * fq) * 2);
#pragma unroll
        for (int vt = 0; vt < 8; ++vt) { const bf16x8 bb = *(const LAS bf16x8*)(Vt + vt_off(16 * vt + fr, 32 * ks + 8 * fq)); o[vt] = __builtin_amdgcn_mfma_f32_16x16x32_bf16(a, bb, o[vt], 0, 0, 0); }
    }
    {   const int il = i0 + fr; const float dff = ex2(lgf2 * (float)(il + 1)), dbb = ex2(lgb2 * (float)(128 - il));
#pragma unroll
        for (int ks = 0; ks < 4; ++ks) {
            float qv[8]; unpack8(*(const LAS u32x4*)(Qs + il * 144 + (32 * (ks & 1) + 8 * fq) * 2), qv);
            const float dec = (ks < 2) ? dff : dbb;
#pragma unroll
            for (int e = 0; e < 8; ++e) qv[e] *= dec;
            const u32x4 pa = pack8(qv); const bf16x8 a = __builtin_bit_cast(bf16x8, pa);
#pragma unroll
            for (int vt = 0; vt < 8; ++vt) { const bf16x8 bb = *(const LAS bf16x8*)(Ss + (16 * vt + fr) * 272 + (32 * ks + 8 * fq) * 2); o[vt] = __builtin_amdgcn_mfma_f32_16x16x32_bf16(a, bb, o[vt], 0, 0, 0); }
        }
    }
    float gw_[8];
#pragma unroll
    for (int vt = 0; vt < 8; ++vt) gw_[vt] = gnw[h * DV + 16 * vt + fr];
#pragma unroll
    for (int r = 0; r < 4; ++r) {
        float sm = 0.f;
#pragma unroll
        for (int vt = 0; vt < 8; ++vt) sm += o[vt][r];
        sm += __shfl_xor(sm, 1); sm += __shfl_xor(sm, 2); sm += __shfl_xor(sm, 4); sm += __shfl_xor(sm, 8);
        const float mu = sm * (1.f / DV); float vs = 0.f;
#pragma unroll
        for (int vt = 0; vt < 8; ++vt) { const float d = o[vt][r] - mu; vs += d * d; }
        vs += __shfl_xor(vs, 1); vs += __shfl_xor(vs, 2); vs += __shfl_xor(vs, 4); vs += __shfl_xor(vs, 8);
        const float rstd = rsqrtf(vs * (1.f / DV) + EPS);
#pragma unroll
        for (int vt = 0; vt < 8; ++vt) *(LAS bf16*)(Ps + (i0 + 4 * fq + r) * 272 + (16 * vt + fr) * 2) = f2bf((o[vt][r] - mu) * rstd * gw_[vt]);
    }
    asm volatile("s_waitcnt lgkmcnt(0)" ::: "memory");
#pragma unroll
    for (int i = 0; i < 4; ++i) { const int idx = lane + 64 * i, row = i0 + (idx >> 4), seg = idx & 15;
        float y[8], g[8]; unpack8(*(const LAS u32x4*)(Ps + row * 272 + seg * 16), y); unpack8(gcur[i], g);
#pragma unroll
        for (int e = 0; e < 8; ++e) y[e] *= silu_(g[e]);
        *(u32x4*)(YN + (grow0 + row) * DM + h * DV + seg * 8) = pack8(y); }
    WG_BARRIER();
}
#define XB_TMO      128
#define XB_XCNT(j)  (256  + 64 * (j))
#define XB_XSUB(j)  (1280 + 64 * (j))
#define XB_XGEN(j)  (2304 + 64 * (j))
#define XB_TOP      3328
#define XB_TOPGEN   3392
#define XCD_BAR_WORDS 3456
#define XB_SPIN_CAP (1u << 18)

__device__ __forceinline__ unsigned xb_ld(unsigned* p)              { return __hip_atomic_load(p, __ATOMIC_RELAXED, __HIP_MEMORY_SCOPE_AGENT); }
__device__ __forceinline__ unsigned xb_add(unsigned* p, unsigned v) { return __hip_atomic_fetch_add(p, v, __ATOMIC_RELAXED, __HIP_MEMORY_SCOPE_AGENT); }
__device__ __forceinline__ unsigned xb_xcc_id() { return (unsigned)__builtin_amdgcn_s_getreg((3 << 11) | 20) & 0xFu; }
#define XB_SPIN(cond, bar) do { unsigned _sp = 0; while (cond) { __builtin_amdgcn_s_sleep(1); \
    if ((++_sp & 255u) == 0u) { if (xb_ld(&(bar)[XB_TMO])) break; if (_sp > XB_SPIN_CAP) { atomicAdd(&(bar)[XB_TMO], 1u); break; } } } } while (0)

struct XcdBarrier {
    unsigned* bar; unsigned x;
    volatile LAS unsigned* st;
};

__device__ __forceinline__ XcdBarrier xcd_barrier_post(unsigned* bar, volatile LAS unsigned* st) {
    XcdBarrier b; b.bar = bar; b.x = xb_xcc_id(); b.st = st;
    if (threadIdx.x == 0) (void)xb_add(&bar[XB_XCNT(b.x)], 1u);
    return b;
}
__device__ __forceinline__ void xcd_barrier_complete(unsigned* bar, unsigned x, unsigned& nloc, unsigned& nx) {
    const unsigned G = gridDim.x * gridDim.y * gridDim.z;
    unsigned sum, cnt, mine, sp = 0u;
    for (;;) {
        sum = 0u; cnt = 0u; mine = 0u;
#pragma unroll
        for (unsigned j = 0; j < 16; ++j) { const unsigned c = xb_ld(&bar[XB_XCNT(j)]); sum += c; cnt += (c > 0u) ? 1u : 0u; mine = (j == x) ? c : mine; }
        if (sum == G) break;
        __builtin_amdgcn_s_sleep(1);
        if ((++sp & 255u) == 0u) { if (xb_ld(&bar[XB_TMO])) break; if (sp > XB_SPIN_CAP) { atomicAdd(&bar[XB_TMO], 1u); break; } }
    }
    nloc = mine > 0u ? mine : 1u; nx = cnt > 0u ? cnt : 1u;
}

__device__ __forceinline__ void xcd_barrier(const XcdBarrier& b) {
    asm volatile("s_waitcnt vmcnt(0)" ::: "memory");
    __syncthreads();
    if (threadIdx.x == 0) {
        unsigned* bar = b.bar;
        __builtin_amdgcn_s_waitcnt(0);
        unsigned nloc = b.st[0], nx = b.st[1];
        if (nloc == 0u) { xcd_barrier_complete(bar, b.x, nloc, nx); b.st[0] = nloc; b.st[1] = nx; }
        const unsigned old = xb_add(&bar[XB_XSUB(b.x)], 1u);
        const unsigned gen = old / nloc;
        if (old + 1u == (gen + 1u) * nloc) {
            __builtin_amdgcn_fence(__ATOMIC_RELEASE, "agent");
            asm volatile("s_waitcnt vmcnt(0)" ::: "memory");
            const unsigned og = xb_add(&bar[XB_TOP], 1u);
            const unsigned tg = og / nx;
            if (og + 1u == (tg + 1u) * nx) xb_add(&bar[XB_TOPGEN], 1u);
            else XB_SPIN(xb_ld(&bar[XB_TOPGEN]) == tg, bar);
            __builtin_amdgcn_fence(__ATOMIC_ACQUIRE, "agent");
            xb_add(&bar[XB_XGEN(b.x)], 1u);
            asm volatile("s_waitcnt vmcnt(0)" ::: "memory");
        } else {
            XB_SPIN(xb_ld(&bar[XB_XGEN(b.x)]) == gen, bar);
            __builtin_amdgcn_fence(__ATOMIC_ACQUIRE, "agent");
            asm volatile("s_waitcnt vmcnt(0)" ::: "memory");
        }
    }
    __syncthreads();
}

struct Args { const float* in[21]; float* out; unsigned char* ws; int ph_lo, ph_hi; };
__global__ void __launch_bounds__(NTHR) mk_fwd(Args args) {
    extern __shared__ __attribute__((aligned(16))) unsigned char lds_raw[];
    LAS unsigned char* lds = (LAS unsigned char*)lds_raw;
    cg::grid_group grid = cg::this_grid();
    const int tid = threadIdx.x, lane = tid & 63, wave = __builtin_amdgcn_readfirstlane(tid >> 6);
    const int G = gridDim.x, bx = blockIdx.x, gw = bx * NWAVES + wave, NGW = G * NWAVES;
    const float* x = args.in[0]; const float* cnd = args.in[1]; const float* ctx = args.in[2]; const float* cctx = args.in[3];
    const float* w_ada = args.in[4]; const float* b_ada = args.in[5]; const float* norm_mix = args.in[6]; const float* norm_ffn = args.in[7];
    const float* w_in = args.in[8]; const float* w_pool = args.in[9]; const float* pscale = args.in[10]; const float* dec_f = args.in[11]; const float* dec_b = args.in[12];
    const float* gn_w = args.in[13]; const float* w_pa = args.in[14]; const float* w_rb = args.in[15]; const float* w_o = args.in[16];
    const float* w_ff1 = args.in[17]; const float* w_ff3 = args.in[18]; const float* w_ff2 = args.in[19]; const float* norm_final = args.in[20];
    float* out = args.out; unsigned char* ws = args.ws;
    bf16* W13T = (bf16*)(ws + WS_W13); bf16* W2T = (bf16*)(ws + WS_W2); bf16* WcT = (bf16*)(ws + WS_WCOMB); bf16* WrbT = (bf16*)(ws + WS_WRB); bf16* WoT = (bf16*)(ws + WS_WO);
    float* MODP = (float*)(ws + WS_MODP); float* MOD = (float*)(ws + WS_MOD);
    bf16* Z = (bf16*)(ws + WS_Z); bf16* WinT = (bf16*)(ws + WS_WIN); bf16* H = (bf16*)(ws + WS_H); bf16* HC = (bf16*)(ws + WS_HC); bf16* ZC = (bf16*)(ws + WS_ZC);
    bf16* Db = (bf16*)(ws + WS_D); bf16* ST = (bf16*)(ws + WS_ST); bf16* MG = (bf16*)(ws + WS_MERGED); bf16* H2 = (bf16*)(ws + WS_H2); bf16* HMID = (bf16*)(ws + WS_HMID);
    bf16* AT = (bf16*)out; bf16* YN = (bf16*)out;
    const int lo = args.ph_lo, hi = args.ph_hi;
    const bool one_launch = (hi - lo) > 1;
    volatile LAS unsigned* xst = (volatile LAS unsigned*)(lds + LDS_BYTES - 64);
    unsigned* xbar = (unsigned*)ws;
    if (one_launch) {
        if (tid == 0) { xst[0] = 0u; xst[1] = 0u; }
        if (bx == 0) for (int i = tid; i < XCD_BAR_WORDS; i += NTHR) __hip_atomic_store(xbar + i, 0u, __ATOMIC_RELAXED, __HIP_MEMORY_SCOPE_AGENT);
        __syncthreads();
    }
    XcdBarrier xb; xb.bar = xbar; xb.x = 0; xb.st = xst;
#define IN(k) (lo <= (k) && (k) < hi)
#define SEAM(k) do { if (IN(k) && IN((k) + 1)) { if ((k) == 0) { grid.sync(); xb = xcd_barrier_post(xbar, xst); } else xcd_barrier(xb); } } while (0)

    if (IN(0)) for (int rep_ = 0; rep_ < REPS[0]; ++rep_) {
        LAS float* scr = (LAS float*)(lds + wave * 16384);
        constexpr int I_ADA = 96 * NKC, I_WC = 512, I_IN = (DM / 64) * (INW / 32), I_F1 = (DM / 64) * (DFF / 32), I_F2 = (DFF / 64) * (DM / 32), I_SQ = (DM / 64) * (DM / 32);
        constexpr int NIT = I_ADA + I_WC + I_IN + 2 * I_F1 + I_F2 + 2 * I_SQ;
        for (int it = gw; it < NIT; it += NGW) {
            int r = it;
            if (r < I_ADA) { ada_item(cnd, cctx, w_ada, MODP, r, lane); continue; } r -= I_ADA;
            if (r < I_WC) { wcomb_item(w_pool, pscale, w_pa, WcT, r, lane); continue; } r -= I_WC;
            if (r < I_IN) { transpose_item(w_in, DM, INW, WinT, 0, scr, r, lane); continue; } r -= I_IN;
            if (r < I_F1) { transpose_item(w_ff1, DM, DFF, W13T, 1, scr, r, lane); continue; } r -= I_F1;
            if (r < I_F1) { transpose_item(w_ff3, DM, DFF, W13T, 2, scr, r, lane); continue; } r -= I_F1;
            if (r < I_F2) { transpose_item(w_ff2, DFF, DM, W2T, 0, scr, r, lane); continue; } r -= I_F2;
            if (r < I_SQ) { transpose_item(w_rb, DM, DM, WrbT, 0, scr, r, lane); continue; } r -= I_SQ;
            transpose_item(w_o, DM, DM, WoT, 0, scr, r, lane);
        }
    }
    SEAM(0);
    if (IN(1)) for (int rep_ = 0; rep_ < REPS[1]; ++rep_) {
        p1_norm(lds, x, ctx, norm_mix, b_ada, MODP, H, HC, bx, G, tid, wave, lane);
        for (int i = bx * NTHR + tid; i < 9 * MODW; i += G * NTHR) { float s = b_ada[i % MODW];
#pragma unroll
            for (int kc = 0; kc < NKC; ++kc) s += MODP[(size_t)kc * 9 * MODW + i];
            MOD[i] = s; }
    }
    SEAM(1);
    if (IN(2)) for (int rep_ = 0; rep_ < REPS[2]; ++rep_) {
        pg8::Gemm g{H, WinT, HC, WinT + (size_t)K_OFF * DM, DM}; pg8::StaticOrder S; S.init(MT, INW, G, bx, MCX, 1536);
        EpiZ E{Z, ZC};
        pg8::gemm_phase<EpiZ, pg8::StaticOrder, true, true>(lds, g, S, E);
    }
    SEAM(2);
    if (IN(3)) for (int rep_ = 0; rep_ < REPS[3]; ++rep_) {
        constexpr int N_A = NB * NH * NPOS, N_P = NB * 4 * 32;
        {   APre pre; int it = bx;
            if (it < N_A) a_load(pre, Z, ZC, it, tid);
            while (it < N_A) { const int nx = it + G; a_item(lds, pre, Z, ZC, AT, dec_f, dec_b, it, nx < N_A ? nx : -1, tid, wave, lane); it = nx; } }
        for (int it = bx; it < N_P; it += G) { const int g = 3 - (it >> 8), rem = it & 255, b = rem >> 5, rr = rem & 31;
            if (g == 3) pool_item<3>(lds, Z, Db, b, rr, tid); else if (g == 2) pool_item<2>(lds, Z, Db, b, rr, tid); else if (g == 1) pool_item<1>(lds, Z, Db, b, rr, tid); else pool_item<0>(lds, Z, Db, b, rr, tid); }
    }
    SEAM(3);
    if (IN(4)) for (int rep_ = 0; rep_ < REPS[4]; ++rep_) {
        for (int it = bx; it < NB * NH * 4; it += G) { const int bh = it >> 2, q = it & 3, h = bh & 7;
            scan_item(AT, ST, log2_sigmoid(dec_f[h]), log2_sigmoid(dec_b[h]), bh, q, tid); }
    }
    SEAM(4);
    if (IN(5)) for (int rep_ = 0; rep_ < REPS[5]; ++rep_) {
        constexpr int N_R = NB * NH * NCH;
        R3Pre pre; int it = bx;
        if (it < N_R) r3_load(pre, Z, ST, it, tid, wave, lane);
        while (it < N_R) { const int nx = it + G; r3_item(lds, pre, Z, ST, YN, gn_w, dec_f, dec_b, it, nx < N_R ? nx : -1, tid, wave, lane); it = nx; }
    }
    SEAM(5);
    if (IN(6)) for (int rep_ = 0; rep_ < REPS[6]; ++rep_) {
        { pg8::Gemm g{Db, WcT, Db, WcT, PWD}; pg8::StaticOrder S; S.init(MT, DM, G, bx); EpiGate<false> E{Z, GA_OFF, MG};
          pg8::gemm_phase<EpiGate<false>, pg8::StaticOrder, true, true>(lds, g, S, E); }
        { pg8::Gemm g{YN, WrbT, YN, WrbT, DM}; pg8::StaticOrder S; S.init(MT, DM, G, bx); EpiGate<true> E{Z, GB_OFF, MG};
          pg8::gemm_phase<EpiGate<true>, pg8::StaticOrder, true, true>(lds, g, S, E); }
    }
    SEAM(6);
    if (IN(7)) for (int rep_ = 0; rep_ < REPS[7]; ++rep_) {
        pg8::Gemm g{MG, WoT, MG, WoT, DM}; pg8::StaticOrder S; S.init(MT, DM, G, bx); EpiRes E{x, out, MOD, 2 * DM};
        pg8::gemm_phase<EpiRes, pg8::StaticOrder, true, true>(lds, g, S, E);
    }
    SEAM(7);
    if (IN(8)) for (int rep_ = 0; rep_ < REPS[8]; ++rep_) p8_norm(out, norm_ffn, MOD, H2, bx, G, wave, lane);
    SEAM(8);
    if (IN(9)) for (int rep_ = 0; rep_ < REPS[9]; ++rep_) {
        pg8::Gemm g{H2, W13T, H2, W13T, DM}; pg8::StaticOrder S; S.init(MT, 2 * DFF, G, bx); EpiSwiglu E{HMID};
        pg8::gemm_phase<EpiSwiglu, pg8::StaticOrder, true, true>(lds, g, S, E);
    }
    SEAM(9);
    if (IN(10)) for (int rep_ = 0; rep_ < REPS[10]; ++rep_) {
        pg8::Gemm g{HMID, W2T, HMID, W2T, DFF}; pg8::StaticOrder S; S.init(MT, DM, G, bx); EpiRes E{out, out, MOD, 5 * DM};
        pg8::gemm_phase<EpiRes, pg8::StaticOrder, true, true>(lds, g, S, E);
    }
    SEAM(10);
    if (IN(11)) p11_norm(out, norm_final, gw, NGW, lane);
#undef IN
#undef SEAM
}

extern "C" void kernel_launch(void* const* d_in, const int* in_sizes, int n_in, void* d_out, int out_size, void* d_ws, size_t ws_size, hipStream_t stream) {
    static int grid = 0;
    if (grid == 0) {
        if (n_in != 21 || out_size != MT * DM || ws_size < WS_END) { fprintf(stderr, "kernel_launch: unexpected problem (n_in %d, out %d, ws %zu)\n", n_in, out_size, ws_size); grid = -1; return; }
        int dev = 0, cus = 0, per_cu = 0;
        (void)hipGetDevice(&dev); (void)hipDeviceGetAttribute(&cus, hipDeviceAttributeMultiprocessorCount, dev);
        if (hipFuncSetAttribute((const void*)mk_fwd, hipFuncAttributeMaxDynamicSharedMemorySize, LDS_BYTES) != hipSuccess) { fprintf(stderr, "kernel_launch: hipFuncSetAttribute failed\n"); grid = -1; return; }
        if (hipOccupancyMaxActiveBlocksPerMultiprocessor(&per_cu, (const void*)mk_fwd, NTHR, LDS_BYTES) != hipSuccess || per_cu < 1) per_cu = 1;
        (void)hipGetLastError();
        if (cus <= 0) cus = 256;
        grid = cus * per_cu;
    }
    if (grid < 0) return;
    Args a{};
    for (int i = 0; i < 21; ++i) a.in[i] = (const float*)d_in[i];
    a.out = (float*)d_out; a.ws = (unsigned char*)d_ws;
#if MK_PER_PHASE
    for (int p = 0; p < NPHASE; ++p) { a.ph_lo = p; a.ph_hi = p + 1; hipLaunchKernelGGL(mk_fwd, dim3(grid), dim3(NTHR), LDS_BYTES, stream, a); }
#else
    a.ph_lo = 0; a.ph_hi = NPHASE;
    void* kargs[] = {(void*)&a};
    hipError_t e = hipLaunchCooperativeKernel((const void*)mk_fwd, dim3(grid), dim3(NTHR), kargs, LDS_BYTES, stream);
    if (e != hipSuccess) fprintf(stderr, "kernel_launch: cooperative launch failed: %s (grid %d)\n", hipGetErrorString(e), grid);
#endif
}
```
